# Optimizing an MI355X kernel written in HIP

```python
import math
import jax, jax.numpy as jnp
from jax import lax
import numpy as np

D_MODEL = 1024
BATCH = 16
SEQ = 4096
DEPTH = 2

N_A = DEPTH // 2
N_B = DEPTH - N_A

E_A = D_MODEL
CONV_WIDTH = 3
CONV_GROUPS = 16

N_HEADS = 8
QK_NOPE = 64
QK_ROPE = 32
V_HEAD = 64
KV_RANK = 256
Q_RANK = 384
E_B = N_HEADS * V_HEAD
ROPE_THETA = 10000.0
Q_BLOCK = 128
SOFTMAX_SCALE = 1.0 / math.sqrt(QK_NOPE + QK_ROPE)

EPS = 1e-6

kernel_name = "yoco_shortconv_mla_hybrid"


def rms_norm(x, g):
    xf = x.astype(jnp.float32)
    y = xf * lax.rsqrt(jnp.mean(xf * xf, axis=-1, keepdims=True) + EPS)
    return (y * g.astype(jnp.float32)).astype(x.dtype)


def rope_tables(positions, dtype):
    inv_freq = ROPE_THETA ** (-jnp.arange(0, QK_ROPE, 2, dtype=jnp.float32) / QK_ROPE)
    ang = positions.astype(jnp.float32)[..., None] * inv_freq
    return jnp.cos(ang).astype(dtype), jnp.sin(ang).astype(dtype)


def apply_rope(x, cos, sin):
    x1, x2 = jnp.split(x, 2, axis=-1)
    return jnp.concatenate([x1 * cos - x2 * sin, x1 * sin + x2 * cos], axis=-1)


def conv_mixer(x, norm_g, w_in, conv_w, w_out):
    S = x.shape[1]
    h = rms_norm(x, norm_g)
    proj = h @ w_in
    b, c, u, g = jnp.split(proj, 4, axis=-1)
    v = c * u
    vp = jnp.pad(v, ((0, 0), (CONV_WIDTH - 1, 0), (0, 0)))
    conv = conv_w[0] * vp[:, 0:S]
    for k in range(1, CONV_WIDTH):
        conv = conv + conv_w[k] * vp[:, k:k + S]
    y = jax.nn.silu(g) * b * conv
    return y @ w_out


def shared_kv(s, kv_norm, w_dkv, ckv_norm, w_ukv, cos, sin):
    Bsz, S, _ = s.shape
    h = rms_norm(s, kv_norm)
    ckr = h @ w_dkv
    c_kv, k_rope = ckr[..., :KV_RANK], ckr[..., KV_RANK:]
    c_kv = rms_norm(c_kv, ckv_norm)
    kv = (c_kv @ w_ukv).reshape(Bsz, S, N_HEADS, QK_NOPE + V_HEAD)
    k_nope, v = kv[..., :QK_NOPE], kv[..., QK_NOPE:]
    k_rope = apply_rope(k_rope, cos, sin)
    return k_nope, k_rope, v


def causal_attention(q_nope, q_rope, k_nope, k_rope, v):
    Bsz, S, H, _ = q_nope.shape
    nb = S // Q_BLOCK
    kpos = jnp.arange(S)

    def one_block(args):
        qn, qr, i = args
        sc = (jnp.einsum('bqhd,bkhd->bhqk', qn, k_nope)
              + jnp.einsum('bqhr,bkr->bhqk', qr, k_rope))
        sc = sc.astype(jnp.float32) * SOFTMAX_SCALE
        qpos = i * Q_BLOCK + jnp.arange(Q_BLOCK)
        mask = kpos[None, :] <= qpos[:, None]
        sc = jnp.where(mask[None, None], sc, -jnp.inf)
        p = jax.nn.softmax(sc, axis=-1).astype(v.dtype)
        return jnp.einsum('bhqk,bkhv->bqhv', p, v)

    qn_b = q_nope.reshape(Bsz, nb, Q_BLOCK, H, QK_NOPE).transpose(1, 0, 2, 3, 4)
    qr_b = q_rope.reshape(Bsz, nb, Q_BLOCK, H, QK_ROPE).transpose(1, 0, 2, 3, 4)
    out = lax.map(one_block, (qn_b, qr_b, jnp.arange(nb)))
    return out.transpose(1, 0, 2, 3, 4).reshape(Bsz, S, H, V_HEAD)


def mla_layer(x, norm_g, w_in, q_norm, w_uq, w_out, k_nope, k_rope, v, cos, sin):
    Bsz, S, _ = x.shape
    h = rms_norm(x, norm_g)
    proj = h @ w_in
    c_q, g = proj[..., :Q_RANK], proj[..., Q_RANK:]
    q = (rms_norm(c_q, q_norm) @ w_uq).reshape(Bsz, S, N_HEADS, QK_NOPE + QK_ROPE)
    q_nope, q_rope = q[..., :QK_NOPE], q[..., QK_NOPE:]
    q_rope = apply_rope(q_rope, cos[:, :, None, :], sin[:, :, None, :])
    o = causal_attention(q_nope, q_rope, k_nope, k_rope, v).reshape(Bsz, S, E_B)
    return (o * jax.nn.silu(g)) @ w_out


def setup_inputs(seed: int = 0) -> dict:
    key = jax.random.key(seed)
    ks = jax.random.split(key, 16)
    f32 = jnp.float32

    def w(k, shape, fan_in):
        return jax.random.normal(k, shape, f32) * (fan_in ** -0.5)

    def gain(k, shape):
        return 1.0 + 0.1 * jax.random.normal(k, shape, f32)

    x = jax.random.normal(ks[0], (BATCH, SEQ, D_MODEL), f32)
    positions = jnp.broadcast_to(jnp.arange(SEQ, dtype=jnp.int32), (BATCH, SEQ))
    return {
        "x": x,
        "positions": positions,
        "a_norm": gain(ks[1], (N_A, D_MODEL)),
        "a_w_in": w(ks[2], (N_A, D_MODEL, 4 * E_A), D_MODEL),
        "a_conv": w(ks[3], (N_A, CONV_WIDTH, E_A), CONV_WIDTH),
        "a_w_out": w(ks[4], (N_A, E_A, D_MODEL), E_A),
        "kv_norm": gain(ks[5], (D_MODEL,)),
        "w_dkv": w(ks[6], (D_MODEL, KV_RANK + QK_ROPE), D_MODEL),
        "ckv_norm": gain(ks[7], (KV_RANK,)),
        "w_ukv": w(ks[8], (KV_RANK, N_HEADS * (QK_NOPE + V_HEAD)), KV_RANK),
        "b_norm": gain(ks[9], (N_B, D_MODEL)),
        "b_w_in": w(ks[10], (N_B, D_MODEL, Q_RANK + E_B), D_MODEL),
        "b_q_norm": gain(ks[11], (N_B, Q_RANK)),
        "b_w_uq": w(ks[12], (N_B, Q_RANK, N_HEADS * (QK_NOPE + QK_ROPE)), Q_RANK),
        "b_w_out": w(ks[13], (N_B, E_B, D_MODEL), E_B),
        "final_norm": gain(ks[14], (D_MODEL,)),
    }


def reference(x, positions, a_norm, a_w_in, a_conv, a_w_out, kv_norm, w_dkv, ckv_norm,
              w_ukv, b_norm, b_w_in, b_q_norm, b_w_uq, b_w_out, final_norm):
    cos, sin = rope_tables(positions, x.dtype)
    k_nope = k_rope = v = None
    for layer in range(DEPTH):
        if layer < N_A:
            x = x + conv_mixer(x, a_norm[layer], a_w_in[layer], a_conv[layer], a_w_out[layer])
            if layer == N_A - 1:
                k_nope, k_rope, v = shared_kv(x, kv_norm, w_dkv, ckv_norm, w_ukv, cos, sin)
        else:
            j = layer - N_A
            x = x + mla_layer(x, b_norm[j], b_w_in[j], b_q_norm[j], b_w_uq[j], b_w_out[j],
                              k_nope, k_rope, v, cos, sin)
    return rms_norm(x, final_norm)
```

```cpp
#include <hip/hip_runtime.h>
#include <cstdio>
#include <cstdint>
#include <cmath>
namespace pg8 {
#define PG8_LAS __attribute__((address_space(3)))
typedef unsigned short bf16_t;
typedef short bf16x8 __attribute__((ext_vector_type(8)));
typedef float f32x4 __attribute__((ext_vector_type(4)));
typedef unsigned u32x4 __attribute__((ext_vector_type(4)));
constexpr int BM = 256, BK = 64, HALF = 128, HTB = HALF * BK * 2  , STAGE_BYTES = 8 * HTB, NXCD = 8, WGM = 8;

__host__ __device__ __forceinline__ int lds_byte(int r, int c) { const int st = (r >> 4) * 2 + (c >> 5), rr = r & 15, cc = c & 31, ob = rr * 64 + cc * 2; return st * 1024 + (ob ^ (((ob >> 9) & 1) << 5)); }
__host__ __device__ __forceinline__ void stage_rc(int b, int& R, int& C) { const int st = b / 1024, sb = b % 1024, swz = sb ^ (((sb >> 9) & 1) << 5); R = (st >> 1) * 16 + swz / 64; C = (st & 1) * 32 + (swz % 64) / 2; }
__host__ __device__ __forceinline__ int perm32(int rho) { const int n = rho >> 4, i = rho & 15; return 8 * (i >> 2) + 4 * n + (i & 3); }

struct Unit { int pm, pn; };
struct Gemm { const bf16_t* A; const bf16_t* Bt; int M, N, K; };

struct StaticOrder {
    int nM, nN, nwg, G, c;
    __host__ __device__ void init(int M, int N, int G_, int c_) { nM = M / BM; nN = N / BM; nwg = nM * nN; G = G_; c = c_; }
    __host__ __device__ bool next(int i, Unit& u) const {
        const long L = (long)i * G + c; if (L >= nwg) return false;
        int wgid = (int)L; { const int q = nwg / NXCD, r = nwg % NXCD, xcd = wgid % NXCD, off = wgid / NXCD; wgid = (xcd < r ? xcd * (q + 1) : r * (q + 1) + (xcd - r) * q) + off; }
        const int nig = WGM * nN, gid = wgid / nig, fm = gid * WGM, gsz = (nM - fm) < WGM ? (nM - fm) : WGM;
        u.pm = fm + ((wgid % nig) % gsz); u.pn = (wgid % nig) / gsz; return true;
    }
    __device__ __forceinline__ void a_ready(const Unit&) const {}
    __device__ __forceinline__ void done(const Unit&) const {}
};
__device__ __forceinline__ unsigned cvt_pk_bf16(float lo, float hi) { unsigned r; asm volatile("v_cvt_pk_bf16_f32 %0, %1, %2" : "=v"(r) : "v"(lo), "v"(hi)); return r; }
typedef float f32x2 __attribute__((ext_vector_type(2)));
__device__ __forceinline__ float bf_lo(unsigned w) { return __uint_as_float(w << 16); }
__device__ __forceinline__ float bf_hi(unsigned w) { return __uint_as_float(w & 0xffff0000u); }
__device__ __forceinline__ float silu_f(float g) { return g * __builtin_amdgcn_rcpf(1.0f + __builtin_amdgcn_exp2f(-1.4426950408889634f * g)); }
__device__ __forceinline__ u32x4 pack8(const f32x4 a, const f32x4 b) { u32x4 w; w.x = cvt_pk_bf16(a[0], a[1]); w.y = cvt_pk_bf16(a[2], a[3]); w.z = cvt_pk_bf16(b[0], b[1]); w.w = cvt_pk_bf16(b[2], b[3]); return w; }
__device__ __forceinline__ float sq4(const f32x4 a) { return (a[0] * a[0] + a[1] * a[1]) + (a[2] * a[2] + a[3] * a[3]); }
__device__ __forceinline__ float sum16f(const float* p) { const f32x4 a = *(const f32x4*)p, b = *(const f32x4*)(p + 4), c = *(const f32x4*)(p + 8), d = *(const f32x4*)(p + 12);
    return ((a[0] + a[1]) + (a[2] + a[3])) + ((b[0] + b[1]) + (b[2] + b[3])) + (((c[0] + c[1]) + (c[2] + c[3])) + ((d[0] + d[1]) + (d[2] + d[3]))); }

struct EpiConvIn {
    static constexpr bool PERM = false, AFTER_DRAIN = false;
    bf16_t* VG; const float* r0;
    __device__ __forceinline__ void operator()(const f32x4 (&acc)[2][2][4][2], const Unit& u, int wr, int wc, int fr, int fq) const {
        const int grp = u.pn * 16 + wc * 4 + fq;
#pragma unroll
        for (int ai = 0; ai < 2; ++ai)
#pragma unroll
            for (int m = 0; m < 4; ++m) { const int row = u.pm * BM + ai * HALF + wr * 64 + m * 16 + fr; const float s = r0[row];
                const f32x4 b = acc[ai][0][m][0] * s, c = acc[ai][0][m][1] * s, uu = acc[ai][1][m][0] * s, g = acc[ai][1][m][1] * s;
                const f32x4 v = c * uu; f32x4 gb; gb[0] = silu_f(g[0]) * b[0]; gb[1] = silu_f(g[1]) * b[1]; gb[2] = silu_f(g[2]) * b[2]; gb[3] = silu_f(g[3]) * b[3];
                *(u32x4*)(VG + ((size_t)row * 256 + grp) * 8) = pack8(v, gb); }
    }
};
template <bool BF16OUT> struct EpiResid {
    static constexpr bool PERM = false, AFTER_DRAIN = false;
    bf16_t* XB; float* OUT; float* SS;
    __device__ __forceinline__ void operator()(const f32x4 (&acc)[2][2][4][2], const Unit& u, int wr, int wc, int fr, int fq) const {
#pragma unroll
        for (int ai = 0; ai < 2; ++ai)
#pragma unroll
            for (int m = 0; m < 4; ++m) { const int row = u.pm * BM + ai * HALF + wr * 64 + m * 16 + fr; float ss = 0.f;
#pragma unroll
                for (int bj = 0; bj < 2; ++bj) { const int col0 = u.pn * BM + bj * HALF + wc * 32 + 8 * fq; bf16_t* xp = XB + (size_t)row * 1024 + col0; const u32x4 xw = *(const u32x4*)xp;
                    f32x4 a = acc[ai][bj][m][0], b = acc[ai][bj][m][1];
                    a[0] += bf_lo(xw.x); a[1] += bf_hi(xw.x); a[2] += bf_lo(xw.y); a[3] += bf_hi(xw.y); b[0] += bf_lo(xw.z); b[1] += bf_hi(xw.z); b[2] += bf_lo(xw.w); b[3] += bf_hi(xw.w);
                    ss += sq4(a) + sq4(b);
                    if (BF16OUT) *(u32x4*)xp = pack8(a, b); else { float* op = OUT + (size_t)row * 1024 + col0; *(f32x4*)op = a; *(f32x4*)(op + 4) = b; } }
                ss += __shfl_xor(ss, 16); ss += __shfl_xor(ss, 32);
                if (fq == 0) SS[(size_t)row * 16 + u.pn * 4 + wc] = ss; }
    }
};
struct EpiLatent {
    static constexpr bool PERM = false, AFTER_DRAIN = false;
    bf16_t *CKV, *CQ, *KR, *SG; const float* SS1; float *SSKV, *SSQ; const float* CS; float eps;
    __device__ __forceinline__ void operator()(const f32x4 (&acc)[2][2][4][2], const Unit& u, int wr, int wc, int fr, int fq) const {
        const int pn = u.pn;
#pragma unroll
        for (int ai = 0; ai < 2; ++ai)
#pragma unroll
            for (int m = 0; m < 4; ++m) { const int row = u.pm * BM + ai * HALF + wr * 64 + m * 16 + fr;
                const float r1 = __builtin_amdgcn_rsqf(sum16f(SS1 + (size_t)row * 16) * (1.0f / 1024.0f) + eps);
                const f32x4 a0 = acc[ai][0][m][0] * r1, b0 = acc[ai][0][m][1] * r1, a1 = acc[ai][1][m][0] * r1, b1 = acc[ai][1][m][1] * r1;
                const int c0 = wc * 32 + 8 * fq;
                if (pn <= 1) { bf16_t* dst = (pn == 0 ? CKV + (size_t)row * 256 : CQ + (size_t)row * 384) + c0;
                    *(u32x4*)dst = pack8(a0, b0); *(u32x4*)(dst + 128) = pack8(a1, b1);
                    float ss = (sq4(a0) + sq4(b0)) + (sq4(a1) + sq4(b1)); ss += __shfl_xor(ss, 16); ss += __shfl_xor(ss, 32);
                    if (fq == 0) { if (pn == 0) SSKV[(size_t)row * 4 + wc] = ss; else SSQ[(size_t)row * 8 + wc] = ss; } }
                else if (pn == 2) { *(u32x4*)(CQ + (size_t)row * 384 + 256 + c0) = pack8(a0, b0);
                    float ss = sq4(a0) + sq4(b0); ss += __shfl_xor(ss, 16); ss += __shfl_xor(ss, 32);
                    if (fq == 0) SSQ[(size_t)row * 8 + 4 + wc] = ss;
                    if (wc == 0) { const f32x4 cs = *(const f32x4*)(CS + (size_t)row * 32 + 4 * fq), sn = *(const f32x4*)(CS + (size_t)row * 32 + 16 + 4 * fq);
                        const f32x4 lo = a1 * cs - b1 * sn, hi = a1 * sn + b1 * cs; *(u32x4*)(KR + (size_t)row * 32 + 8 * fq) = pack8(lo, hi); } }
                else { f32x4 s0, s1, s2, s3;
#pragma unroll
                    for (int e = 0; e < 4; ++e) { s0[e] = silu_f(a0[e]); s1[e] = silu_f(b0[e]); s2[e] = silu_f(a1[e]); s3[e] = silu_f(b1[e]); }
                    bf16_t* dst = SG + (size_t)row * 512 + (pn - 3) * 256 + c0; *(u32x4*)dst = pack8(s0, s1); *(u32x4*)(dst + 128) = pack8(s2, s3); } }
    }
};
struct EpiKV {
    static constexpr bool PERM = false, AFTER_DRAIN = false;
    bf16_t *KN, *VB; const float* SSKV; float eps;
    __device__ __forceinline__ void operator()(const f32x4 (&acc)[2][2][4][2], const Unit& u, int wr, int wc, int fr, int fq) const {
        bf16_t* base = (u.pn < 2 ? KN : VB) + (u.pn & 1) * 256 + wc * 32 + 8 * fq;
#pragma unroll
        for (int ai = 0; ai < 2; ++ai)
#pragma unroll
            for (int m = 0; m < 4; ++m) { const int row = u.pm * BM + ai * HALF + wr * 64 + m * 16 + fr; const f32x4 q = *(const f32x4*)(SSKV + (size_t)row * 4);
                const float s = __builtin_amdgcn_rsqf(((q[0] + q[1]) + (q[2] + q[3])) * (1.0f / 256.0f) + eps);
#pragma unroll
                for (int bj = 0; bj < 2; ++bj) *(u32x4*)(base + (size_t)row * 512 + bj * HALF) = pack8(acc[ai][bj][m][0] * s, acc[ai][bj][m][1] * s); }
    }
};
struct EpiQ {
    static constexpr bool PERM = false, AFTER_DRAIN = false;
    bf16_t* QB; const float* SSQ; const float* CS; float eps, c2;
    __device__ __forceinline__ void operator()(const f32x4 (&acc)[2][2][4][2], const Unit& u, int wr, int wc, int fr, int fq) const {
#pragma unroll
        for (int ai = 0; ai < 2; ++ai)
#pragma unroll
            for (int m = 0; m < 4; ++m) { const int row = u.pm * BM + ai * HALF + wr * 64 + m * 16 + fr;
                const f32x4 qa = *(const f32x4*)(SSQ + (size_t)row * 8), qb = *(const f32x4*)(SSQ + (size_t)row * 8 + 4);
                const float s = __builtin_amdgcn_rsqf((((qa[0] + qa[1]) + (qa[2] + qa[3])) + ((qb[0] + qb[1]) + (qb[2] + qb[3]))) * (1.0f / 384.0f) + eps) * c2;
#pragma unroll
                for (int bj = 0; bj < 2; ++bj) { const int L0 = u.pn * BM + bj * HALF + wc * 32 + 8 * fq, d0 = L0 % 96;
                    f32x4 a = acc[ai][bj][m][0] * s, b = acc[ai][bj][m][1] * s;
                    if (d0 >= 64) { const int i0 = ((d0 - 64) >> 3) * 4; const f32x4 cs = *(const f32x4*)(CS + (size_t)row * 32 + i0), sn = *(const f32x4*)(CS + (size_t)row * 32 + 16 + i0);
                        const f32x4 lo = a * cs - b * sn, hi = a * sn + b * cs; a = lo; b = hi; }
                    *(u32x4*)(QB + (size_t)row * 768 + L0) = pack8(a, b); } }
    }
};
template <class Epi, class Sched, bool ALIGN_EPI = false, bool SP2 = false>
__device__ __forceinline__ void gemm_phase(PG8_LAS unsigned char* lds, const Gemm g, const Sched& S, const Epi& E) {
    const int tid = threadIdx.x, wid = __builtin_amdgcn_readfirstlane(tid >> 6), lane = tid & 63, wr = wid >> 2, wc = wid & 3, fr = lane & 15, fq = lane >> 4;
    const int K = g.K, nt = K / BK;
    unsigned voffA[2], voffB[2];
#pragma unroll
    for (int i = 0; i < 2; ++i) { int R, C; stage_rc(tid * 16 + i * 8192, R, C); const int Rb = Epi::PERM ? ((R & ~31) + perm32(R & 31)) : R;
        voffA[i] = (unsigned)(R * K + C) * 2u; voffB[i] = (unsigned)(Rb * K + C) * 2u; }
    const size_t kstep = (size_t)(BK * 2);
    const size_t hstep = (size_t)HALF * K * 2;
    const size_t tstep = 2 * hstep;
    const unsigned ldsw = (unsigned)wid * 1024u;
    const int aoff = lds_byte(wr * 64 + fr, fq * 8), boff = lds_byte(wc * 32 + fr, fq * 8);
#define PG8_SA(b, h) (((b) * 2 + (h)) * HTB)
#define PG8_SB(b, h) ((4 + (b) * 2 + (h)) * HTB)
#define PG8_STAGE(bufoff, gbase, voff) do { _Pragma("unroll") for (int _i = 0; _i < 2; ++_i) \
        __builtin_amdgcn_global_load_lds((const unsigned*)((const char*)(gbase) + (voff)[_i]), (PG8_LAS unsigned*)(lds + (bufoff) + ldsw + _i * 8192), 16, 0, 0); } while (0)
#define PG8_LDA(dst, b, h) do { _Pragma("unroll") for (int m = 0; m < 4; ++m) _Pragma("unroll") for (int k = 0; k < 2; ++k) dst[m][k] = *(const PG8_LAS bf16x8*)(lds + PG8_SA(b, h) + aoff + m * 2048 + k * 1024); } while (0)
#define PG8_LDB(dst, b, h) do { _Pragma("unroll") for (int n = 0; n < 2; ++n) _Pragma("unroll") for (int k = 0; k < 2; ++k) dst[n][k] = *(const PG8_LAS bf16x8*)(lds + PG8_SB(b, h) + boff + n * 2048 + k * 1024); } while (0)
#define PG8_MMA(ai, bj, At, Bt) do { __builtin_amdgcn_s_setprio(1); _Pragma("unroll") for (int m = 0; m < 4; ++m) _Pragma("unroll") for (int n = 0; n < 2; ++n) _Pragma("unroll") for (int k = 0; k < 2; ++k) \
        acc[ai][bj][m][n] = __builtin_amdgcn_mfma_f32_16x16x32_bf16(Bt[n][k], At[m][k], acc[ai][bj][m][n], 0, 0, 0); __builtin_amdgcn_s_setprio(0); } while (0)
#define PG8_WAIT_V(n) asm volatile("s_waitcnt vmcnt(" #n ")" ::: "memory")
#define PG8_WAIT_L(n) asm volatile("s_waitcnt lgkmcnt(" #n ")" ::: "memory")
#define PG8_BAR __builtin_amdgcn_s_barrier()
#define PG8_SCHED __builtin_amdgcn_sched_barrier(0)
    Unit cur, nxt; int ui = 0;
    if (!S.next(0, cur)) return;
    f32x4 acc[2][2][4][2];
#pragma unroll
    for (int a = 0; a < 2; ++a)
#pragma unroll
        for (int b = 0; b < 2; ++b)
#pragma unroll
            for (int m = 0; m < 4; ++m)
#pragma unroll
                for (int n = 0; n < 2; ++n) acc[a][b][m][n] = (f32x4){0.f, 0.f, 0.f, 0.f};
    bf16x8 At[4][2], B0[2][2], B1[2][2];
    const char* cA = (const char*)g.A + (size_t)cur.pm * tstep; const char* cB = (const char*)g.Bt + (size_t)cur.pn * tstep;
    S.a_ready(cur);
    if constexpr (SP2) {
        PG8_STAGE(PG8_SB(0, 0), cB, voffB); PG8_STAGE(PG8_SB(0, 1), cB + hstep, voffB); PG8_STAGE(PG8_SA(0, 0), cA, voffA); PG8_STAGE(PG8_SA(0, 1), cA + hstep, voffA);
        if (wr == 1) PG8_BAR;
        PG8_WAIT_V(2); PG8_BAR;
        PG8_STAGE(PG8_SB(1, 0), cB + kstep, voffB); PG8_STAGE(PG8_SA(1, 0), cA + kstep, voffA); PG8_STAGE(PG8_SB(1, 1), cB + hstep + kstep, voffB);
        PG8_WAIT_V(6); PG8_BAR;
    } else {
        PG8_STAGE(PG8_SB(0, 0), cB, voffB); PG8_STAGE(PG8_SA(0, 0), cA, voffA); PG8_STAGE(PG8_SB(0, 1), cB + hstep, voffB); PG8_STAGE(PG8_SA(0, 1), cA + hstep, voffA);
        if (wr == 1) PG8_BAR;
        PG8_WAIT_V(4); PG8_BAR;
        PG8_STAGE(PG8_SB(1, 0), cB + kstep, voffB); PG8_STAGE(PG8_SA(1, 0), cA + kstep, voffA); PG8_STAGE(PG8_SB(1, 1), cB + hstep + kstep, voffB);
        PG8_WAIT_V(6); PG8_BAR;
    }
    for (;;) {
        const bool has_next = S.next(ui + 1, nxt);
        const char* nA = has_next ? (const char*)g.A + (size_t)nxt.pm * tstep : cA; const char* nB = has_next ? (const char*)g.Bt + (size_t)nxt.pn * tstep : cB;
        for (int t = 0; t < nt; t += 2) {
            const bool last = (t == nt - 2);
            const char* a1 = cA + (size_t)(t + 1) * kstep;
            const char* a2 = last ? nA : cA + (size_t)(t + 2) * kstep; const char* b2 = last ? nB : cB + (size_t)(t + 2) * kstep;
            const char* a3 = a2 + kstep; const char* b3 = b2 + kstep;
            if (last && has_next) S.a_ready(nxt);
            if constexpr (SP2) {
            PG8_LDB(B0, 0, 0); PG8_LDB(B1, 0, 1); PG8_SCHED; PG8_LDA(At, 0, 0); PG8_STAGE(PG8_SA(1, 1), a1 + hstep, voffA);
            PG8_WAIT_V(8); PG8_WAIT_L(0); PG8_BAR; PG8_MMA(0, 0, At, B0); PG8_MMA(0, 1, At, B1); PG8_BAR; PG8_SCHED;
            PG8_LDA(At, 0, 1); PG8_STAGE(PG8_SB(0, 0), b2, voffB); PG8_STAGE(PG8_SB(0, 1), b2 + hstep, voffB); PG8_STAGE(PG8_SA(0, 0), a2, voffA);
            PG8_WAIT_V(8); PG8_WAIT_L(0); PG8_BAR; PG8_MMA(1, 0, At, B0); PG8_MMA(1, 1, At, B1); PG8_BAR; PG8_SCHED;
            PG8_LDB(B0, 1, 0); PG8_LDB(B1, 1, 1); PG8_SCHED; PG8_LDA(At, 1, 0); PG8_STAGE(PG8_SA(0, 1), a2 + hstep, voffA);
            PG8_WAIT_V(8); PG8_WAIT_L(0); PG8_BAR; PG8_MMA(0, 0, At, B0); PG8_MMA(0, 1, At, B1); PG8_BAR; PG8_SCHED;
            PG8_LDA(At, 1, 1); PG8_STAGE(PG8_SB(1, 0), b3, voffB); PG8_STAGE(PG8_SB(1, 1), b3 + hstep, voffB); PG8_STAGE(PG8_SA(1, 0), a3, voffA);
            PG8_WAIT_V(8); PG8_WAIT_L(0); PG8_BAR; PG8_MMA(1, 0, At, B0); PG8_MMA(1, 1, At, B1); PG8_BAR; PG8_SCHED;
            } else {
            PG8_LDB(B0, 0, 0); PG8_SCHED; PG8_LDA(At, 0, 0); PG8_STAGE(PG8_SA(1, 1), a1 + hstep, voffA);
            PG8_WAIT_L(8); PG8_BAR; PG8_WAIT_L(0); PG8_MMA(0, 0, At, B0); PG8_BAR; PG8_SCHED;
            PG8_LDB(B1, 0, 1); PG8_STAGE(PG8_SB(0, 0), b2, voffB);
            PG8_BAR; PG8_WAIT_L(0); PG8_MMA(0, 1, At, B1); PG8_BAR;
            PG8_LDA(At, 0, 1); PG8_STAGE(PG8_SA(0, 0), a2, voffA);
            PG8_BAR; PG8_WAIT_L(0); PG8_MMA(1, 0, At, B0); PG8_BAR; PG8_SCHED;
            PG8_STAGE(PG8_SB(0, 1), b2 + hstep, voffB);
            PG8_WAIT_V(6); PG8_BAR; PG8_MMA(1, 1, At, B1); PG8_BAR;
            PG8_LDB(B0, 1, 0); PG8_SCHED; PG8_LDA(At, 1, 0); PG8_STAGE(PG8_SA(0, 1), a2 + hstep, voffA);
            PG8_WAIT_L(8); PG8_BAR; PG8_WAIT_L(0); PG8_MMA(0, 0, At, B0); PG8_BAR; PG8_SCHED;
            PG8_LDB(B1, 1, 1); PG8_STAGE(PG8_SB(1, 0), b3, voffB);
            PG8_BAR; PG8_WAIT_L(0); PG8_MMA(0, 1, At, B1); PG8_BAR;
            PG8_LDA(At, 1, 1); PG8_STAGE(PG8_SA(1, 0), a3, voffA);
            PG8_BAR; PG8_WAIT_L(0); PG8_MMA(1, 0, At, B0); PG8_BAR; PG8_SCHED;
            PG8_STAGE(PG8_SB(1, 1), b3 + hstep, voffB);
            PG8_WAIT_V(6); PG8_BAR; PG8_MMA(1, 1, At, B1); PG8_BAR;
            }
        }
        if constexpr (ALIGN_EPI) { if (wr == 0) PG8_BAR; }
        if constexpr (!Epi::AFTER_DRAIN) { E(acc, cur, wr, wc, fr, fq); S.done(cur); }
        if (!has_next) break;
#pragma unroll
        for (int a = 0; a < 2; ++a)
#pragma unroll
            for (int b = 0; b < 2; ++b)
#pragma unroll
                for (int m = 0; m < 4; ++m)
#pragma unroll
                    for (int n = 0; n < 2; ++n) acc[a][b][m][n] = (f32x4){0.f, 0.f, 0.f, 0.f};
        cur = nxt; cA = nA; cB = nB; ++ui;
        if constexpr (ALIGN_EPI) { if (wr == 1) PG8_BAR; }
    }
    PG8_WAIT_V(0);
    if constexpr (!ALIGN_EPI) { if (wr == 0) PG8_BAR; }
    PG8_BAR;
    if constexpr (Epi::AFTER_DRAIN) { E.fused(acc, cur, wr, wc, fr, fq, lds, wid, lane); S.done(cur); }
#undef PG8_SA
#undef PG8_SB
#undef PG8_STAGE
#undef PG8_LDA
#undef PG8_LDB
#undef PG8_MMA
#undef PG8_WAIT_V
#undef PG8_WAIT_L
#undef PG8_BAR
#undef PG8_SCHED
}
}
#include <hip/hip_bf16.h>
namespace att {
using bf16x8 = __attribute__((ext_vector_type(8))) short;
using s16x4 = __attribute__((ext_vector_type(4))) short;
using f32x16 = __attribute__((ext_vector_type(16))) float;
using f32x4 = __attribute__((ext_vector_type(4))) float;
using u32x4 = __attribute__((ext_vector_type(4))) unsigned;
typedef unsigned short bf16_t;
#define ATT_LAS __attribute__((address_space(3)))
constexpr int SEQ = 4096, NH = 8, QP = 768, KP = 512, RP = 32, VP = 512, GP = 512;
constexpr int KSLOT = 12288, VSLOT = 8192, L_K = 0, L_V = 2 * KSLOT, L_WS = L_V + 2 * VSLOT, L_OST = L_WS + 8 * 256, ATT_LDS = L_OST + 8 * 8192;
__device__ __forceinline__ int crow(int r, int hi) { return (r & 3) + 8 * (r >> 2) + 4 * hi; }
__device__ __forceinline__ void glds16(const void* gsrc, unsigned lds_dst) { unsigned keep;
    asm volatile("s_mov_b32 %0, m0\n\ts_mov_b32 m0, %2\n\ts_nop 0\n\tglobal_load_lds_dwordx4 %1, off\n\ts_mov_b32 m0, %0" : "=&s"(keep) : "v"(gsrc), "s"(lds_dst) : "memory"); }
__device__ __forceinline__ unsigned cvtpk(float lo, float hi) { typedef float f2 __attribute__((ext_vector_type(2))); typedef __bf16 b2 __attribute__((ext_vector_type(2))); f2 v = {lo, hi}; b2 b = __builtin_convertvector(v, b2); return __builtin_bit_cast(unsigned, b); }
#define MX3(a, b, c) __builtin_fmaxf(__builtin_fmaxf((a), (b)), (c))
__device__ __forceinline__ float rowmax(const f32x16& p0, const f32x16& p1) {
    float a = MX3(p0[0], p0[1], p1[0]), b = MX3(p0[2], p0[3], p1[1]); a = MX3(a, p1[2], p1[3]);
#pragma unroll
    for (int r = 4; r < 16; r += 4) { a = MX3(a, p0[r], p0[r + 1]); b = MX3(b, p0[r + 2], p0[r + 3]); a = MX3(a, p1[r], p1[r + 1]); b = MX3(b, p1[r + 2], p1[r + 3]); }
    float m = __builtin_fmaxf(a, b); auto rr = __builtin_amdgcn_permlane32_swap(__float_as_uint(m), __float_as_uint(m), false, false);
    return __builtin_fmaxf(__uint_as_float(rr[0]), __uint_as_float(rr[1])); }
__device__ __forceinline__ void cmask(f32x16& p0, f32x16& p1, int jb, int qrel, int hi) {
    const int kb = 64 * jb + 4 * hi;
#pragma unroll
    for (int r = 0; r < 16; ++r) { const int kv = kb + (r & 3) + 8 * (r >> 2); if (kv > qrel) p0[r] = -INFINITY; if (kv + 32 > qrel) p1[r] = -INFINITY; } }

__device__ __forceinline__ void attn_unit(int b, int h, int qb, const bf16_t* Q, const bf16_t* KN, const bf16_t* KR, const bf16_t* V, const bf16_t* SG, bf16_t* OG, ATT_LAS unsigned char* lds) {
    const int tid = threadIdx.x, lane = tid & 63, r32 = lane & 31, hi = lane >> 5; const int wid = __builtin_amdgcn_readfirstlane(tid >> 6);
    const long rowbase = (long)b * SEQ; const int q0 = qb * 256, NT = (q0 + 256) / 64;
    const bf16_t* Qw = Q + (rowbase + q0 + wid * 32) * QP + h * 96;
    const bf16_t* ksrc0 = KN + (rowbase + lane) * KP + h * 64 + wid * 8;
    const bf16_t* ksrc1 = KR + (rowbase + lane) * RP + (wid & 3) * 8;
    const bf16_t* vsrc = V + (rowbase + 16 * (wid & 3) + (lane >> 2)) * VP + h * 64 + (wid >> 2) * 32 + (lane & 3) * 8;
    const unsigned lds0 = (unsigned)(uintptr_t)lds;
    const unsigned kdst0 = lds0 + L_K + wid * 1024, kdst1 = lds0 + L_K + (8 + (wid & 3)) * 1024, vdst = lds0 + L_V + wid * 1024;
#define ATT_DMA(t, s) do { glds16(ksrc0 + (long)(t) * 64 * KP, (unsigned)__builtin_amdgcn_readfirstlane(kdst0 + (s) * KSLOT)); \
        glds16(ksrc1 + (long)(t) * 64 * RP, (unsigned)__builtin_amdgcn_readfirstlane(kdst1 + (s) * KSLOT)); \
        glds16(vsrc + (long)(t) * 64 * VP, (unsigned)__builtin_amdgcn_readfirstlane(vdst + (s) * VSLOT)); } while (0)
    ATT_LAS float* wsf = (ATT_LAS float*)(lds + L_WS) + wid * 64;
    ATT_DMA(0, 0);
    bf16x8 qr[6];
#pragma unroll
    for (int d0 = 0; d0 < 6; ++d0) qr[d0] = *reinterpret_cast<const bf16x8*>(&Qw[(long)r32 * QP + d0 * 16 + hi * 8]);
    float m_run = -1e30f, l_run = 0.f; f32x16 o[2]; o[0] = f32x16{}; o[1] = f32x16{};
    const int qrel = wid * 32 + r32;
    const unsigned kfrag = L_K + hi * 1024 + r32 * 16;
    const unsigned vb0 = lds0 + L_V + ((lane >> 4) & 1) * 32 + (lane & 3) * 8 + (4 * hi + ((lane & 15) >> 2)) * 64;
    for (int t = 0; t < NT; ++t) {
        const int s = t & 1;
        asm volatile("s_waitcnt vmcnt(0) lgkmcnt(0)\n\ts_barrier" ::: "memory");
        if (t + 1 < NT) ATT_DMA(t + 1, s ^ 1);
        f32x16 p0 = f32x16{}, p1 = f32x16{};
        const ATT_LAS unsigned char* kb = lds + kfrag + s * KSLOT;
#pragma unroll
        for (int d0 = 0; d0 < 6; ++d0) { const bf16x8 b0 = *(const ATT_LAS bf16x8*)(kb + d0 * 2048), b1 = *(const ATT_LAS bf16x8*)(kb + d0 * 2048 + 512);
            p0 = __builtin_amdgcn_mfma_f32_32x32x16_bf16(b0, qr[d0], p0, 0, 0, 0); p1 = __builtin_amdgcn_mfma_f32_32x32x16_bf16(b1, qr[d0], p1, 0, 0, 0); }
        if (t >= NT - 4) cmask(p0, p1, t - (NT - 4), qrel, hi);
        const float rm = rowmax(p0, p1), mn = __builtin_fmaxf(m_run, rm), alpha = __builtin_amdgcn_exp2f(m_run - mn); m_run = mn;
        float sum = 0.f;
#pragma unroll
        for (int r = 0; r < 16; ++r) { p0[r] = __builtin_amdgcn_exp2f(p0[r] - mn); p1[r] = __builtin_amdgcn_exp2f(p1[r] - mn); sum += p0[r] + p1[r]; }
        l_run = l_run * alpha + sum;
        if (hi == 0) wsf[r32] = alpha;
        u32x4 pw0, pw1, pw2, pw3;
        pw0 = (u32x4){cvtpk(p0[0], p0[1]), cvtpk(p0[2], p0[3]), cvtpk(p0[4], p0[5]), cvtpk(p0[6], p0[7])}; pw1 = (u32x4){cvtpk(p0[8], p0[9]), cvtpk(p0[10], p0[11]), cvtpk(p0[12], p0[13]), cvtpk(p0[14], p0[15])};
        pw2 = (u32x4){cvtpk(p1[0], p1[1]), cvtpk(p1[2], p1[3]), cvtpk(p1[4], p1[5]), cvtpk(p1[6], p1[7])}; pw3 = (u32x4){cvtpk(p1[8], p1[9]), cvtpk(p1[10], p1[11]), cvtpk(p1[12], p1[13]), cvtpk(p1[14], p1[15])};
        asm volatile("s_waitcnt lgkmcnt(0)" ::: "memory");
#pragma unroll
        for (int d = 0; d < 2; ++d)
#pragma unroll
            for (int r = 0; r < 16; ++r) o[d][r] *= wsf[crow(r, hi)];
        const unsigned vb = vb0 + s * VSLOT;
#pragma unroll
        for (int d0 = 0; d0 < 2; ++d0) { s16x4 lo[4], hh[4];
#pragma unroll
            for (int ks = 0; ks < 4; ++ks) {
                asm volatile("ds_read_b64_tr_b16 %0,%1 offset:%c2" : "=&v"(lo[ks]) : "v"(vb), "i"(d0 * 4096 + ks * 1024) : "memory");
                asm volatile("ds_read_b64_tr_b16 %0,%1 offset:%c2" : "=&v"(hh[ks]) : "v"(vb), "i"(d0 * 4096 + ks * 1024 + 512) : "memory"); }
            asm volatile("s_waitcnt lgkmcnt(0)" ::: "memory"); __builtin_amdgcn_sched_barrier(0);
#define ATT_PK(k) (bf16x8){lo[k][0], lo[k][1], lo[k][2], lo[k][3], hh[k][0], hh[k][1], hh[k][2], hh[k][3]}
            o[d0] = __builtin_amdgcn_mfma_f32_32x32x16_bf16(__builtin_bit_cast(bf16x8, pw0), ATT_PK(0), o[d0], 0, 0, 0);
            o[d0] = __builtin_amdgcn_mfma_f32_32x32x16_bf16(__builtin_bit_cast(bf16x8, pw1), ATT_PK(1), o[d0], 0, 0, 0);
            o[d0] = __builtin_amdgcn_mfma_f32_32x32x16_bf16(__builtin_bit_cast(bf16x8, pw2), ATT_PK(2), o[d0], 0, 0, 0);
            o[d0] = __builtin_amdgcn_mfma_f32_32x32x16_bf16(__builtin_bit_cast(bf16x8, pw3), ATT_PK(3), o[d0], 0, 0, 0);
#undef ATT_PK
        }
    }
    { auto rr = __builtin_amdgcn_permlane32_swap(__float_as_uint(l_run), __float_as_uint(l_run), false, false); l_run = __uint_as_float(rr[0]) + __uint_as_float(rr[1]); }
    if (hi == 0) wsf[32 + r32] = __builtin_amdgcn_rcpf(l_run);
    asm volatile("s_waitcnt lgkmcnt(0)" ::: "memory");
    ATT_LAS float* stg = (ATT_LAS float*)(lds + L_OST) + wid * 2048;
#pragma unroll
    for (int r = 0; r < 16; ++r) { const int orow = crow(r, hi); const float rl = wsf[32 + orow];
        stg[orow * 64 + r32] = o[0][r] * rl; stg[orow * 64 + 32 + r32] = o[1][r] * rl; }
    asm volatile("s_waitcnt lgkmcnt(0)" ::: "memory");
#pragma unroll
    for (int i = 0; i < 4; ++i) { const int row = i * 8 + (lane >> 3), ch = lane & 7; const long grow = rowbase + q0 + wid * 32 + row;
        const f32x4 a = *(const ATT_LAS f32x4*)(stg + row * 64 + ch * 8), c = *(const ATT_LAS f32x4*)(stg + row * 64 + ch * 8 + 4);
        const u32x4 g = *(const u32x4*)(SG + grow * GP + h * 64 + ch * 8);
        u32x4 w; w.x = cvtpk(a[0] * __uint_as_float(g.x << 16), a[1] * __uint_as_float(g.x & 0xffff0000u)); w.y = cvtpk(a[2] * __uint_as_float(g.y << 16), a[3] * __uint_as_float(g.y & 0xffff0000u));
        w.z = cvtpk(c[0] * __uint_as_float(g.z << 16), c[1] * __uint_as_float(g.z & 0xffff0000u)); w.w = cvtpk(c[2] * __uint_as_float(g.w << 16), c[3] * __uint_as_float(g.w & 0xffff0000u));
        *(u32x4*)(OG + grow * GP + h * 64 + ch * 8) = w; }
    asm volatile("s_waitcnt lgkmcnt(0)" ::: "memory");
#undef ATT_DMA
}
#undef MX3
}
#define GAS __attribute__((address_space(1)))
#define LAS __attribute__((address_space(3)))
typedef unsigned short bf16;
typedef unsigned v4u __attribute__((ext_vector_type(4)));
typedef float f32x4 __attribute__((ext_vector_type(4)));
typedef short bf16x8 __attribute__((ext_vector_type(8)));
typedef GAS unsigned gu32;
typedef GAS unsigned long long gu64;
#define RLX_AGENT __ATOMIC_RELAXED, __HIP_MEMORY_SCOPE_AGENT
#define LDS_WAIT() asm volatile("s_waitcnt lgkmcnt(0)" ::: "memory")
#define VM_WAIT() asm volatile("s_waitcnt vmcnt(0)" ::: "memory")
__device__ __forceinline__ unsigned long long rt() { return __builtin_amdgcn_s_memrealtime(); }
__device__ __forceinline__ unsigned f2bf(float f) { unsigned u = __builtin_bit_cast(unsigned, f); return (u + 0x7fffu + ((u >> 16) & 1u)) >> 16; }
__device__ __forceinline__ unsigned pk2(float lo, float hi) { return f2bf(lo) | (f2bf(hi) << 16); }

#define XB_TMO      128
#define XB_XCNT(j)  (256  + 64 * (j))
#define XB_XSUB(j)  (1280 + 64 * (j))
#define XB_XGEN(j)  (2304 + 64 * (j))
#define XB_TOP      3328
#define XB_TOPGEN   3392
#define XCD_BAR_WORDS 3456
#define XB_SPIN_CAP (1u << 18)

__device__ __forceinline__ unsigned xb_ld(unsigned* p)              { return __hip_atomic_load(p, __ATOMIC_RELAXED, __HIP_MEMORY_SCOPE_AGENT); }
__device__ __forceinline__ unsigned xb_add(unsigned* p, unsigned v) { return __hip_atomic_fetch_add(p, v, __ATOMIC_RELAXED, __HIP_MEMORY_SCOPE_AGENT); }
__device__ __forceinline__ unsigned xb_xcc_id() { return (unsigned)__builtin_amdgcn_s_getreg((3 << 11) | 20) & 0xFu; }
#define XB_SPIN(cond, bar) do { unsigned _sp = 0; while (cond) { __builtin_amdgcn_s_sleep(1); \
    if ((++_sp & 255u) == 0u) { if (xb_ld(&(bar)[XB_TMO])) break; if (_sp > XB_SPIN_CAP) { atomicAdd(&(bar)[XB_TMO], 1u); break; } } } } while (0)

struct XcdBarrier {
    unsigned* bar; unsigned x;
    volatile LAS unsigned* st;
};

__device__ __forceinline__ XcdBarrier xcd_barrier_post(unsigned* bar, volatile LAS unsigned* st) {
    XcdBarrier b; b.bar = bar; b.x = xb_xcc_id(); b.st = st;
    if (threadIdx.x == 0) (void)xb_add(&bar[XB_XCNT(b.x)], 1u);
    return b;
}
__device__ __forceinline__ void xcd_barrier_complete(unsigned* bar, unsigned x, unsigned& nloc, unsigned& nx) {
    const unsigned G = gridDim.x * gridDim.y * gridDim.z;
    unsigned sum, cnt, mine, sp = 0u;
    for (;;) {
        sum = 0u; cnt = 0u; mine = 0u;
#pragma unroll
        for (unsigned j = 0; j < 16; ++j) { const unsigned c = xb_ld(&bar[XB_XCNT(j)]); sum += c; cnt += (c > 0u) ? 1u : 0u; mine = (j == x) ? c : mine; }
        if (sum == G) break;
        __builtin_amdgcn_s_sleep(1);
        if ((++sp & 255u) == 0u) { if (xb_ld(&bar[XB_TMO])) break; if (sp > XB_SPIN_CAP) { atomicAdd(&bar[XB_TMO], 1u); break; } }
    }
    nloc = mine > 0u ? mine : 1u; nx = cnt > 0u ? cnt : 1u;
}

__device__ __forceinline__ void xcd_barrier(const XcdBarrier& b) {
    asm volatile("s_waitcnt vmcnt(0)" ::: "memory");
    __syncthreads();
    if (threadIdx.x == 0) {
        unsigned* bar = b.bar;
        __builtin_amdgcn_s_waitcnt(0);
        unsigned nloc = b.st[0], nx = b.st[1];
        if (nloc == 0u) { xcd_barrier_complete(bar, b.x, nloc, nx); b.st[0] = nloc; b.st[1] = nx; }
        const unsigned old = xb_add(&bar[XB_XSUB(b.x)], 1u);
        const unsigned gen = old / nloc;
        if (old + 1u == (gen + 1u) * nloc) {
            __builtin_amdgcn_fence(__ATOMIC_RELEASE, "agent");
            asm volatile("s_waitcnt vmcnt(0)" ::: "memory");
            const unsigned og = xb_add(&bar[XB_TOP], 1u);
            const unsigned tg = og / nx;
            if (og + 1u == (tg + 1u) * nx) xb_add(&bar[XB_TOPGEN], 1u);
            else XB_SPIN(xb_ld(&bar[XB_TOPGEN]) == tg, bar);
            __builtin_amdgcn_fence(__ATOMIC_ACQUIRE, "agent");
            xb_add(&bar[XB_XGEN(b.x)], 1u);
            asm volatile("s_waitcnt vmcnt(0)" ::: "memory");
        } else {
            XB_SPIN(xb_ld(&bar[XB_XGEN(b.x)]) == gen, bar);
            __builtin_amdgcn_fence(__ATOMIC_ACQUIRE, "agent");
            asm volatile("s_waitcnt vmcnt(0)" ::: "memory");
        }
    }
    __syncthreads();
}

constexpr int NWAVES = 8;
#ifndef MK_N_LAUNCHES
#define MK_N_LAUNCHES 1
#endif
constexpr int N_PHASES = 9;
constexpr int TOK = 65536, DM = 1024, SEQ = 4096;
constexpr float EPS = 1e-6f;
constexpr float C2 = 0.10206207261596577f * 1.4426950408889634f;
constexpr size_t MiB = 1u << 20;
constexpr size_t WS_CTL = 0, CTL_ZERO_BYTES = 1 * MiB;
constexpr size_t WS_W1 = 2 * MiB;
constexpr size_t WS_W2 = 10 * MiB;
constexpr size_t WS_W3 = 12 * MiB;
constexpr size_t WS_W4A = 15 * MiB;
constexpr size_t WS_W4B = 16 * MiB;
constexpr size_t WS_W5 = 17 * MiB;
constexpr size_t WS_R0 = 18 * MiB;
constexpr size_t WS_SS1 = 19 * MiB;
constexpr size_t WS_SS2 = 23 * MiB;
constexpr size_t WS_SSKV = 27 * MiB;
constexpr size_t WS_SSQ = 28 * MiB;
constexpr size_t WS_CS = 30 * MiB;
constexpr size_t WS_XB = 64 * MiB;
constexpr size_t WS_VG = 192 * MiB;
constexpr size_t WS_Y = 448 * MiB;
constexpr size_t WS_CKV = 576 * MiB;
constexpr size_t WS_CQ = 608 * MiB;
constexpr size_t WS_KR = 656 * MiB;
constexpr size_t WS_SG = 660 * MiB;
constexpr size_t WS_KN = 724 * MiB;
constexpr size_t WS_VB = 788 * MiB;
constexpr size_t WS_QB = 852 * MiB;
constexpr size_t WS_END = 948 * MiB;
constexpr int CW_TMO = 0, CW_BAR = 4096;
constexpr int RING_OFF = 0, RING_BYTES = 131072, LDSCTL_OFF = RING_BYTES, MISC_OFF = LDSCTL_OFF + 320, LDS_BYTES = 147456;
static_assert(att::ATT_LDS <= RING_BYTES, "attention scratch inside the ring region");

struct Args { const float* in[16]; float* out; unsigned char* ws; int ph_lo, ph_hi, li, pad; };

__device__ __forceinline__ float wave_sum(float v) {
#pragma unroll
    for (int o = 1; o < 64; o <<= 1) v += __shfl_xor(v, o);
    return v;
}
__device__ __forceinline__ int lc_of(int cp) { return (cp & ~0x1C) | (((cp >> 2) & 3) << 3) | (((cp >> 4) & 1) << 2); }
__device__ __forceinline__ void wmap(const Args& A, int gemm, int wrow, const float*& W, int& ld, int& col, const float*& gain) {
    const int pn = wrow >> 8, cp = wrow & 255, L = (pn << 8) + lc_of(cp);
    switch (gemm) {
    case 0: { const int bj = cp >> 7, wc = (cp >> 5) & 3, n = (cp >> 4) & 1, fq = (cp >> 2) & 3, e = cp & 3; W = A.in[3]; ld = 4096; col = 1024 * (2 * bj + n) + 64 * pn + 16 * wc + 4 * fq + e; gain = A.in[2]; } break;
    case 1: W = A.in[5]; ld = 1024; col = L; gain = nullptr; break;
    case 2: if (L < 256) { W = A.in[7]; ld = 288; col = L; gain = A.in[6]; }
            else if (L < 640) { W = A.in[11]; ld = 896; col = L - 256; gain = A.in[10]; }
            else if (L < 768) { const int p = L - 640; W = A.in[7]; ld = 288; gain = A.in[6]; col = (p < 32) ? 256 + 4 * (p >> 3) + (p & 3) + 16 * ((p >> 2) & 1) : -1; }
            else { W = A.in[11]; ld = 896; col = 384 + (L - 768); gain = A.in[10]; } break;
    case 3: W = A.in[9]; ld = 1024; gain = A.in[8]; col = (L < 512) ? (L >> 6) * 128 + (L & 63) : ((L - 512) >> 6) * 128 + 64 + (L & 63); break;
    case 4: { const int h = L / 96, d = L % 96; W = A.in[13]; ld = 768; gain = A.in[12]; if (d < 64) col = h * 96 + d; else { const int p = d - 64; col = h * 96 + 64 + 4 * (p >> 3) + (p & 3) + 16 * ((p >> 2) & 1); } } break;
    default: W = A.in[14]; ld = 1024; col = L; gain = nullptr; break;
    }
}
__device__ __forceinline__ void prep_item(const Args& A, int gemm, int K, bf16* WT, LAS float* scr, int item, int lane) {
    const int nblk_k = K / 64, nb = item / nblk_k, kb = item % nblk_k, k0 = 64 * kb, n0 = 32 * nb;
    const float* W; int ld, col; const float* gain; wmap(A, gemm, n0 + (lane & 31), W, ld, col, gain);
#pragma unroll 8
    for (int i = 0; i < 32; ++i) { const int kk = 2 * i + (lane >> 5); float v = 0.f; if (col >= 0) { v = W[(size_t)(k0 + kk) * ld + col]; if (gain) v *= gain[k0 + kk]; } scr[kk * 33 + (lane & 31)] = v; }
    LDS_WAIT(); asm volatile("" ::: "memory");
    const int c = lane & 7;
#pragma unroll
    for (int j = 0; j < 4; ++j) { const int n = (lane >> 3) + 8 * j; const LAS float* s = scr + (8 * c) * 33 + n;
        v4u o; o.x = pk2(s[0 * 33], s[1 * 33]); o.y = pk2(s[2 * 33], s[3 * 33]); o.z = pk2(s[4 * 33], s[5 * 33]); o.w = pk2(s[6 * 33], s[7 * 33]);
        *(GAS v4u*)(WT + (size_t)(n0 + n) * K + k0 + 8 * c) = o; }
    LDS_WAIT(); asm volatile("" ::: "memory");
}

__global__ void __launch_bounds__(NWAVES * 64, 2) yoco_fwd(Args args) {
    extern __shared__ __attribute__((aligned(16))) unsigned char lds_raw[];
    LAS unsigned char* lds = (LAS unsigned char*)lds_raw;
    volatile LAS unsigned* MISC = (volatile LAS unsigned*)(lds + MISC_OFF);
    const int tid = threadIdx.x, lane = tid & 63, wave = __builtin_amdgcn_readfirstlane(tid >> 6);
    const int G = gridDim.x, bx = blockIdx.x, vcu = (G % 8 == 0) ? (bx % 8) * (G / 8) + bx / 8 : bx;
    unsigned char* ws = args.ws;
    gu32* ctl = (gu32*)(ws + WS_CTL);
    bf16 *W1 = (bf16*)(ws + WS_W1), *W2 = (bf16*)(ws + WS_W2), *W3 = (bf16*)(ws + WS_W3), *W4A = (bf16*)(ws + WS_W4A), *W4B = (bf16*)(ws + WS_W4B), *W5 = (bf16*)(ws + WS_W5);
    float *R0 = (float*)(ws + WS_R0), *SS1 = (float*)(ws + WS_SS1), *SS2 = (float*)(ws + WS_SS2), *SSKV = (float*)(ws + WS_SSKV), *SSQ = (float*)(ws + WS_SSQ), *CS = (float*)(ws + WS_CS);
    bf16 *XB = (bf16*)(ws + WS_XB), *VG = (bf16*)(ws + WS_VG), *Y = (bf16*)(ws + WS_Y), *CKV = (bf16*)(ws + WS_CKV), *CQ = (bf16*)(ws + WS_CQ), *KR = (bf16*)(ws + WS_KR),
         *SG = (bf16*)(ws + WS_SG), *KN = (bf16*)(ws + WS_KN), *VB = (bf16*)(ws + WS_VB), *QB = (bf16*)(ws + WS_QB);
    for (int u = tid; u < (LDS_BYTES - LDSCTL_OFF) / 4; u += NWAVES * 64) ((LAS unsigned*)(lds + LDSCTL_OFF))[u] = 0u;
    __syncthreads();
    XcdBarrier bar = xcd_barrier_post((unsigned*)(ctl + CW_BAR) + args.li * XCD_BAR_WORDS, MISC + 8);
    const int lo = args.ph_lo, hi = args.ph_hi;
#define IN(k) (lo <= (k) && (k) < hi)
#define SEAM(k) do { if (IN(k) && IN((k) + 1)) xcd_barrier(bar); } while (0)
    const int gw = vcu * NWAVES + wave, NGW = G * NWAVES, gt = vcu * NWAVES * 64 + tid, NGT = G * NWAVES * 64;

    if (IN(0)) {
        LAS float* scr = (LAS float*)(lds + RING_OFF + wave * 16384);
        constexpr int I0 = 16 * 128, I1 = 16 * 32, I2 = 16 * 40, I3 = 4 * 32, I4 = 6 * 24, I5 = 8 * 32, NITEMS = I0 + I1 + I2 + I3 + I4 + I5;
        for (int it = gw; it < NITEMS; it += NGW) { int r = it;
            if (r < I0) { prep_item(args, 0, 1024, W1, scr, r, lane); continue; } r -= I0;
            if (r < I1) { prep_item(args, 1, 1024, W2, scr, r, lane); continue; } r -= I1;
            if (r < I2) { prep_item(args, 2, 1024, W3, scr, r, lane); continue; } r -= I2;
            if (r < I3) { prep_item(args, 3, 256, W4A, scr, r, lane); continue; } r -= I3;
            if (r < I4) { prep_item(args, 4, 384, W4B, scr, r, lane); continue; } r -= I4;
            prep_item(args, 5, 512, W5, scr, r, lane); }
        const float* x = args.in[0];
        for (int m = gw; m < TOK; m += NGW) { const GAS f32x4* xr = (const GAS f32x4*)(x + (size_t)m * DM) + lane; f32x4 v[4]; float s = 0.f;
#pragma unroll
            for (int j = 0; j < 4; ++j) { v[j] = xr[64 * j]; s += (v[j].x * v[j].x + v[j].y * v[j].y) + (v[j].z * v[j].z + v[j].w * v[j].w); }
            s = wave_sum(s); if (lane == 0) R0[m] = 1.0f / sqrtf(s * (1.0f / DM) + EPS);
            GAS unsigned long long* o8 = (GAS unsigned long long*)(XB + (size_t)m * DM) + lane;
#pragma unroll
            for (int j = 0; j < 4; ++j) o8[64 * j] = (unsigned long long)pk2(v[j].x, v[j].y) | ((unsigned long long)pk2(v[j].z, v[j].w) << 32); }
        const int* pos = (const int*)args.in[1];
        for (int i = gt; i < TOK * 16; i += NGT) { const int m = i >> 4, k = i & 15; const float inv = powf(10000.0f, -(float)k * (1.0f / 16.0f)); const float ang = (float)pos[m] * inv;
            float sn, cs; sincosf(ang, &sn, &cs); CS[(size_t)m * 32 + k] = cs; CS[(size_t)m * 32 + 16 + k] = sn; }
    }
    SEAM(0);
    if (IN(1)) { pg8::Gemm g{XB, W1, TOK, 4096, 1024}; pg8::StaticOrder S; S.init(TOK, 4096, G, bx); pg8::EpiConvIn E{VG, R0};
        pg8::gemm_phase<pg8::EpiConvIn, pg8::StaticOrder, true, true>(lds + RING_OFF, g, S, E); }
    SEAM(1);
    if (IN(2)) { const float* cw = args.in[4];
        for (int it = gt; it < (TOK / 16) * 128; it += NGT) { const int oct = it & 127, rc = it >> 7, t0 = rc * 16, ch = oct * 8;
            float w0[8], w1[8], w2[8];
#pragma unroll
            for (int j = 0; j < 8; ++j) { w0[j] = cw[ch + j]; w1[j] = cw[1024 + ch + j]; w2[j] = cw[2048 + ch + j]; }
            float vm2[8], vm1[8];
            const bool first = (t0 % SEQ) == 0;
#pragma unroll
            for (int h2 = 0; h2 < 2; ++h2) { v4u a = (v4u){0u, 0u, 0u, 0u}, b = a;
                if (!first) { a = *(const GAS v4u*)(VG + ((size_t)(t0 - 2) * 256 + oct * 2 + h2) * 8); b = *(const GAS v4u*)(VG + ((size_t)(t0 - 1) * 256 + oct * 2 + h2) * 8); }
                vm2[4 * h2 + 0] = pg8::bf_lo(a.x); vm2[4 * h2 + 1] = pg8::bf_hi(a.x); vm2[4 * h2 + 2] = pg8::bf_lo(a.y); vm2[4 * h2 + 3] = pg8::bf_hi(a.y);
                vm1[4 * h2 + 0] = pg8::bf_lo(b.x); vm1[4 * h2 + 1] = pg8::bf_hi(b.x); vm1[4 * h2 + 2] = pg8::bf_lo(b.y); vm1[4 * h2 + 3] = pg8::bf_hi(b.y); }
            for (int r = 0; r < 16; ++r) { const int t = t0 + r; float vc[8], gbv[8];
#pragma unroll
                for (int h2 = 0; h2 < 2; ++h2) { const v4u a = *(const GAS v4u*)(VG + ((size_t)t * 256 + oct * 2 + h2) * 8);
                    vc[4 * h2 + 0] = pg8::bf_lo(a.x); vc[4 * h2 + 1] = pg8::bf_hi(a.x); vc[4 * h2 + 2] = pg8::bf_lo(a.y); vc[4 * h2 + 3] = pg8::bf_hi(a.y);
                    gbv[4 * h2 + 0] = pg8::bf_lo(a.z); gbv[4 * h2 + 1] = pg8::bf_hi(a.z); gbv[4 * h2 + 2] = pg8::bf_lo(a.w); gbv[4 * h2 + 3] = pg8::bf_hi(a.w); }
                float yv[8];
#pragma unroll
                for (int j = 0; j < 8; ++j) { yv[j] = gbv[j] * (w0[j] * vm2[j] + w1[j] * vm1[j] + w2[j] * vc[j]); vm2[j] = vm1[j]; vm1[j] = vc[j]; }
                v4u o; o.x = pk2(yv[0], yv[1]); o.y = pk2(yv[2], yv[3]); o.z = pk2(yv[4], yv[5]); o.w = pk2(yv[6], yv[7]);
                *(GAS v4u*)(Y + (size_t)t * DM + ch) = o; } }
    }
    SEAM(2);
    if (IN(3)) { pg8::Gemm g{Y, W2, TOK, 1024, 1024}; pg8::StaticOrder S; S.init(TOK, 1024, G, bx); pg8::EpiResid<true> E{XB, nullptr, SS1};
        pg8::gemm_phase<pg8::EpiResid<true>, pg8::StaticOrder, true, true>(lds + RING_OFF, g, S, E); }
    SEAM(3);
    if (IN(4)) { pg8::Gemm g{XB, W3, TOK, 1280, 1024}; pg8::StaticOrder S; S.init(TOK, 1280, G, bx); pg8::EpiLatent E{CKV, CQ, KR, SG, SS1, SSKV, SSQ, CS, EPS};
        pg8::gemm_phase<pg8::EpiLatent, pg8::StaticOrder, true, true>(lds + RING_OFF, g, S, E); }
    SEAM(4);
    if (IN(5)) {
        { pg8::Gemm g{CKV, W4A, TOK, 1024, 256}; pg8::StaticOrder S; S.init(TOK, 1024, G, bx); pg8::EpiKV E{KN, VB, SSKV, EPS};
          pg8::gemm_phase<pg8::EpiKV, pg8::StaticOrder, true, true>(lds + RING_OFF, g, S, E); }
        { pg8::Gemm g{CQ, W4B, TOK, 768, 384}; pg8::StaticOrder S; S.init(TOK, 768, G, bx); pg8::EpiQ E{QB, SSQ, CS, EPS, C2};
          pg8::gemm_phase<pg8::EpiQ, pg8::StaticOrder, true, true>(lds + RING_OFF, g, S, E); }
    }
    SEAM(5);
    if (IN(6)) {
        const int bh = vcu >> 1, b = bh >> 3, h = bh & 7;
        for (int i = 0; i < 8; ++i) { const int s = 4 * (vcu & 1) + (i >> 1), qb = (i & 1) ? 15 - s : s;
            att::attn_unit(b, h, qb, QB, KN, KR, VB, SG, SG, lds + RING_OFF); }
        asm volatile("s_waitcnt vmcnt(0) lgkmcnt(0)" ::: "memory"); __syncthreads();
    }
    SEAM(6);
    if (IN(7)) { pg8::Gemm g{SG, W5, TOK, 1024, 512}; pg8::StaticOrder S; S.init(TOK, 1024, G, bx); pg8::EpiResid<false> E{XB, args.out, SS2};
        pg8::gemm_phase<pg8::EpiResid<false>, pg8::StaticOrder, true, true>(lds + RING_OFF, g, S, E); }
    SEAM(7);
    if (IN(8)) { const float* gf = args.in[15]; f32x4 gg[4];
#pragma unroll
        for (int j = 0; j < 4; ++j) gg[j] = ((const GAS f32x4*)gf)[lane + 64 * j];
        for (int m = gw; m < TOK; m += NGW) { const float rs = 1.0f / sqrtf(pg8::sum16f(SS2 + (size_t)m * 16) * (1.0f / DM) + EPS);
            GAS f32x4* orow = (GAS f32x4*)(args.out + (size_t)m * DM) + lane;
#pragma unroll
            for (int j = 0; j < 4; ++j) { f32x4 v = orow[64 * j]; orow[64 * j] = v * rs * gg[j]; } }
    }
#undef IN
#undef SEAM
}

extern "C" void kernel_launch(void* const* d_in, const int* in_sizes, int n_in, void* d_out, int out_size, void* d_ws, size_t ws_size, hipStream_t stream) {
    static int grid = 0;
    if (grid == 0) {
        if (n_in != 16 || in_sizes[0] != TOK * DM || out_size != TOK * DM || ws_size < WS_END) { fprintf(stderr, "kernel_launch: unexpected shapes (n_in %d, in0 %d, out %d, ws %zu)\n", n_in, n_in > 0 ? in_sizes[0] : -1, out_size, ws_size); grid = -1; return; }
        int dev = 0, cus = 0, per_cu = 0;
        if (hipGetDevice(&dev) != hipSuccess || hipDeviceGetAttribute(&cus, hipDeviceAttributeMultiprocessorCount, dev) != hipSuccess) { grid = -1; return; }
        if (hipFuncSetAttribute((const void*)yoco_fwd, hipFuncAttributeMaxDynamicSharedMemorySize, LDS_BYTES) != hipSuccess) { fprintf(stderr, "kernel_launch: hipFuncSetAttribute failed\n"); grid = -1; return; }
        if (hipOccupancyMaxActiveBlocksPerMultiprocessor(&per_cu, (const void*)yoco_fwd, NWAVES * 64, LDS_BYTES) != hipSuccess || per_cu < 1) fprintf(stderr, "kernel_launch: occupancy query reports %d\n", per_cu);
        (void)hipGetLastError();
        grid = cus;
        if (grid != 256) fprintf(stderr, "kernel_launch: %d CUs (expected 256)\n", grid);
    }
    if (grid < 0) return;
    (void)hipMemsetAsync((char*)d_ws + WS_CTL, 0, CTL_ZERO_BYTES, stream);
    Args a{};
    for (int i = 0; i < 16; ++i) a.in[i] = (const float*)d_in[i];
    a.out = (float*)d_out; a.ws = (unsigned char*)d_ws;
    constexpr int NL = MK_N_LAUNCHES;
    for (int li = 0; li < NL; ++li) {
        a.ph_lo = (NL == 1) ? 0 : li; a.ph_hi = (NL == 1) ? N_PHASES : li + 1; a.li = (NL == 1) ? 0 : 0;
        hipLaunchKernelGGL(yoco_fwd, dim3(grid), dim3(NWAVES * 64), LDS_BYTES, stream, a);
    }
}
```

```cpp
#include <hip/hip_runtime.h>
#include <cstdio>
#include <cstdint>
#include <cmath>
namespace pg8 {
#define PG8_LAS __attribute__((address_space(3)))
typedef unsigned short bf16_t;
typedef short bf16x8 __attribute__((ext_vector_type(8)));
typedef float f32x4 __attribute__((ext_vector_type(4)));
typedef unsigned u32x4 __attribute__((ext_vector_type(4)));
constexpr int BM = 256, BK = 64, HALF = 128, HTB = HALF * BK * 2  , STAGE_BYTES = 8 * HTB, NXCD = 8, WGM = 8;

__host__ __device__ __forceinline__ int lds_byte(int r, int c) { const int st = (r >> 4) * 2 + (c >> 5), rr = r & 15, cc = c & 31, ob = rr * 64 + cc * 2; return st * 1024 + (ob ^ (((ob >> 9) & 1) << 5)); }
__host__ __device__ __forceinline__ void stage_rc(int b, int& R, int& C) { const int st = b / 1024, sb = b % 1024, swz = sb ^ (((sb >> 9) & 1) << 5); R = (st >> 1) * 16 + swz / 64; C = (st & 1) * 32 + (swz % 64) / 2; }
__host__ __device__ __forceinline__ int perm32(int rho) { const int n = rho >> 4, i = rho & 15; return 8 * (i >> 2) + 4 * n + (i & 3); }

struct Unit { int pm, pn; };
struct Gemm { const bf16_t* A; const bf16_t* Bt; int M, N, K; };

struct StaticOrder {
    int nM, nN, nwg, G, c;
    __host__ __device__ void init(int M, int N, int G_, int c_) { nM = M / BM; nN = N / BM; nwg = nM * nN; G = G_; c = c_; }
    __host__ __device__ bool next(int i, Unit& u) const {
        const long L = (long)i * G + c; if (L >= nwg) return false;
        int wgid = (int)L; { const int q = nwg / NXCD, r = nwg % NXCD, xcd = wgid % NXCD, off = wgid / NXCD; wgid = (xcd < r ? xcd * (q + 1) : r * (q + 1) + (xcd - r) * q) + off; }
        const int nig = WGM * nN, gid = wgid / nig, fm = gid * WGM, gsz = (nM - fm) < WGM ? (nM - fm) : WGM;
        u.pm = fm + ((wgid % nig) % gsz); u.pn = (wgid % nig) / gsz; return true;
    }
    __device__ __forceinline__ void a_ready(const Unit&) const {}
    __device__ __forceinline__ void done(const Unit&) const {}
};
__device__ __forceinline__ unsigned cvt_pk_bf16(float lo, float hi) { unsigned r; asm volatile("v_cvt_pk_bf16_f32 %0, %1, %2" : "=v"(r) : "v"(lo), "v"(hi)); return r; }
typedef float f32x2 __attribute__((ext_vector_type(2)));
__device__ __forceinline__ float bf_lo(unsigned w) { return __uint_as_float(w << 16); }
__device__ __forceinline__ float bf_hi(unsigned w) { return __uint_as_float(w & 0xffff0000u); }
__device__ __forceinline__ float silu_f(float g) { return g * __builtin_amdgcn_rcpf(1.0f + __builtin_amdgcn_exp2f(-1.4426950408889634f * g)); }
__device__ __forceinline__ u32x4 pack8(const f32x4 a, const f32x4 b) { u32x4 w; w.x = cvt_pk_bf16(a[0], a[1]); w.y = cvt_pk_bf16(a[2], a[3]); w.z = cvt_pk_bf16(b[0], b[1]); w.w = cvt_pk_bf16(b[2], b[3]); return w; }
__device__ __forceinline__ float sq4(const f32x4 a) { return (a[0] * a[0] + a[1] * a[1]) + (a[2] * a[2] + a[3] * a[3]); }
__device__ __forceinline__ float sum16f(const float* p) { const f32x4 a = *(const f32x4*)p, b = *(const f32x4*)(p + 4), c = *(const f32x4*)(p + 8), d = *(const f32x4*)(p + 12);
    return ((a[0] + a[1]) + (a[2] + a[3])) + ((b[0] + b[1]) + (b[2] + b[3])) + (((c[0] + c[1]) + (c[2] + c[3])) + ((d[0] + d[1]) + (d[2] + d[3]))); }

struct EpiConvIn {
    static constexpr bool PERM = false, AFTER_DRAIN = false;
    bf16_t* VG; const float* r0;
    __device__ __forceinline__ void operator()(const f32x4 (&acc)[2][2][4][2], const Unit& u, int wr, int wc, int fr, int fq) const {
        const int grp = u.pn * 16 + wc * 4 + fq;
#pragma unroll
        for (int ai = 0; ai < 2; ++ai)
#pragma unroll
            for (int m = 0; m < 4; ++m) { const int row = u.pm * BM + ai * HALF + wr * 64 + m * 16 + fr; const float s = r0[row];
                const f32x4 b = acc[ai][0][m][0] * s, c = acc[ai][0][m][1] * s, uu = acc[ai][1][m][0] * s, g = acc[ai][1][m][1] * s;
                const f32x4 v = c * uu; f32x4 gb; gb[0] = silu_f(g[0]) * b[0]; gb[1] = silu_f(g[1]) * b[1]; gb[2] = silu_f(g[2]) * b[2]; gb[3] = silu_f(g[3]) * b[3];
                *(u32x4*)(VG + ((size_t)row * 256 + grp) * 8) = pack8(v, gb); }
    }
};
template <bool BF16OUT> struct EpiResid {
    static constexpr bool PERM = false, AFTER_DRAIN = false;
    const bf16_t* XB; bf16_t* XO; float* OUT; float* SS;
    __device__ __forceinline__ void operator()(const f32x4 (&acc)[2][2][4][2], const Unit& u, int wr, int wc, int fr, int fq) const {
#pragma unroll
        for (int ai = 0; ai < 2; ++ai)
#pragma unroll
            for (int m = 0; m < 4; ++m) { const int row = u.pm * BM + ai * HALF + wr * 64 + m * 16 + fr; float ss = 0.f;
#pragma unroll
                for (int bj = 0; bj < 2; ++bj) { const int col0 = u.pn * BM + bj * HALF + wc * 32 + 8 * fq; const size_t xo = (size_t)row * 1024 + col0; const u32x4 xw = *(const u32x4*)(XB + xo);
                    f32x4 a = acc[ai][bj][m][0], b = acc[ai][bj][m][1];
                    a[0] += bf_lo(xw.x); a[1] += bf_hi(xw.x); a[2] += bf_lo(xw.y); a[3] += bf_hi(xw.y); b[0] += bf_lo(xw.z); b[1] += bf_hi(xw.z); b[2] += bf_lo(xw.w); b[3] += bf_hi(xw.w);
                    ss += sq4(a) + sq4(b);
                    if (BF16OUT) *(u32x4*)(XO + xo) = pack8(a, b); else { float* op = OUT + xo; *(f32x4*)op = a; *(f32x4*)(op + 4) = b; } }
                ss += __shfl_xor(ss, 16); ss += __shfl_xor(ss, 32);
                if (fq == 0) SS[(size_t)row * 16 + u.pn * 4 + wc] = ss; }
    }
};
struct EpiLatent {
    static constexpr bool PERM = false, AFTER_DRAIN = false;
    bf16_t *CKV, *CQ, *KR, *SG; const float* SS1; float *SSKV, *SSQ; const float* CS; float eps;
    __device__ __forceinline__ void operator()(const f32x4 (&acc)[2][2][4][2], const Unit& u, int wr, int wc, int fr, int fq) const {
        const int pn = u.pn;
#pragma unroll
        for (int ai = 0; ai < 2; ++ai)
#pragma unroll
            for (int m = 0; m < 4; ++m) { const int row = u.pm * BM + ai * HALF + wr * 64 + m * 16 + fr;
                const float r1 = __builtin_amdgcn_rsqf(sum16f(SS1 + (size_t)row * 16) * (1.0f / 1024.0f) + eps);
                const f32x4 a0 = acc[ai][0][m][0] * r1, b0 = acc[ai][0][m][1] * r1, a1 = acc[ai][1][m][0] * r1, b1 = acc[ai][1][m][1] * r1;
                const int c0 = wc * 32 + 8 * fq;
                if (pn <= 1) { bf16_t* dst = (pn == 0 ? CKV + (size_t)row * 256 : CQ + (size_t)row * 384) + c0;
                    *(u32x4*)dst = pack8(a0, b0); *(u32x4*)(dst + 128) = pack8(a1, b1);
                    float ss = (sq4(a0) + sq4(b0)) + (sq4(a1) + sq4(b1)); ss += __shfl_xor(ss, 16); ss += __shfl_xor(ss, 32);
                    if (fq == 0) { if (pn == 0) SSKV[(size_t)row * 4 + wc] = ss; else SSQ[(size_t)row * 8 + wc] = ss; } }
                else if (pn == 2) { *(u32x4*)(CQ + (size_t)row * 384 + 256 + c0) = pack8(a0, b0);
                    float ss = sq4(a0) + sq4(b0); ss += __shfl_xor(ss, 16); ss += __shfl_xor(ss, 32);
                    if (fq == 0) SSQ[(size_t)row * 8 + 4 + wc] = ss;
                    if (wc == 0) { const f32x4 cs = *(const f32x4*)(CS + (size_t)row * 32 + 4 * fq), sn = *(const f32x4*)(CS + (size_t)row * 32 + 16 + 4 * fq);
                        const f32x4 lo = a1 * cs - b1 * sn, hi = a1 * sn + b1 * cs; *(u32x4*)(KR + (size_t)row * 32 + 8 * fq) = pack8(lo, hi); } }
                else { f32x4 s0, s1, s2, s3;
#pragma unroll
                    for (int e = 0; e < 4; ++e) { s0[e] = silu_f(a0[e]); s1[e] = silu_f(b0[e]); s2[e] = silu_f(a1[e]); s3[e] = silu_f(b1[e]); }
                    bf16_t* dst = SG + (size_t)row * 512 + (pn - 3) * 256 + c0; *(u32x4*)dst = pack8(s0, s1); *(u32x4*)(dst + 128) = pack8(s2, s3); } }
    }
};
struct EpiKV {
    static constexpr bool PERM = false, AFTER_DRAIN = false;
    bf16_t *KN, *VB; const float* SSKV; float eps;
    __device__ __forceinline__ void operator()(const f32x4 (&acc)[2][2][4][2], const Unit& u, int wr, int wc, int fr, int fq) const {
        bf16_t* base = (u.pn < 2 ? KN : VB) + (u.pn & 1) * 256 + wc * 32 + 8 * fq;
#pragma unroll
        for (int ai = 0; ai < 2; ++ai)
#pragma unroll
            for (int m = 0; m < 4; ++m) { const int row = u.pm * BM + ai * HALF + wr * 64 + m * 16 + fr; const f32x4 q = *(const f32x4*)(SSKV + (size_t)row * 4);
                const float s = __builtin_amdgcn_rsqf(((q[0] + q[1]) + (q[2] + q[3])) * (1.0f / 256.0f) + eps);
#pragma unroll
                for (int bj = 0; bj < 2; ++bj) *(u32x4*)(base + (size_t)row * 512 + bj * HALF) = pack8(acc[ai][bj][m][0] * s, acc[ai][bj][m][1] * s); }
    }
};
struct EpiQ {
    static constexpr bool PERM = false, AFTER_DRAIN = false;
    bf16_t* QB; const float* SSQ; const float* CS; float eps, c2;
    __device__ __forceinline__ void operator()(const f32x4 (&acc)[2][2][4][2], const Unit& u, int wr, int wc, int fr, int fq) const {
#pragma unroll
        for (int ai = 0; ai < 2; ++ai)
#pragma unroll
            for (int m = 0; m < 4; ++m) { const int row = u.pm * BM + ai * HALF + wr * 64 + m * 16 + fr;
                const f32x4 qa = *(const f32x4*)(SSQ + (size_t)row * 8), qb = *(const f32x4*)(SSQ + (size_t)row * 8 + 4);
                const float s = __builtin_amdgcn_rsqf((((qa[0] + qa[1]) + (qa[2] + qa[3])) + ((qb[0] + qb[1]) + (qb[2] + qb[3]))) * (1.0f / 384.0f) + eps) * c2;
#pragma unroll
                for (int bj = 0; bj < 2; ++bj) { const int L0 = u.pn * BM + bj * HALF + wc * 32 + 8 * fq, d0 = L0 % 96;
                    f32x4 a = acc[ai][bj][m][0] * s, b = acc[ai][bj][m][1] * s;
                    if (d0 >= 64) { const int i0 = ((d0 - 64) >> 3) * 4; const f32x4 cs = *(const f32x4*)(CS + (size_t)row * 32 + i0), sn = *(const f32x4*)(CS + (size_t)row * 32 + 16 + i0);
                        const f32x4 lo = a * cs - b * sn, hi = a * sn + b * cs; a = lo; b = hi; }
                    *(u32x4*)(QB + (size_t)row * 768 + L0) = pack8(a, b); } }
    }
};
template <class Epi, class Sched, bool ALIGN_EPI = false, bool SP2 = false>
__device__ __forceinline__ void gemm_phase(PG8_LAS unsigned char* lds, const Gemm g, const Sched& S, const Epi& E) {
    const int tid = threadIdx.x, wid = __builtin_amdgcn_readfirstlane(tid >> 6), lane = tid & 63, wr = wid >> 2, wc = wid & 3, fr = lane & 15, fq = lane >> 4;
    const int K = g.K, nt = K / BK;
    unsigned voffA[2], voffB[2];
#pragma unroll
    for (int i = 0; i < 2; ++i) { int R, C; stage_rc(tid * 16 + i * 8192, R, C); const int Rb = Epi::PERM ? ((R & ~31) + perm32(R & 31)) : R;
        voffA[i] = (unsigned)(R * K + C) * 2u; voffB[i] = (unsigned)(Rb * K + C) * 2u; }
    const size_t kstep = (size_t)(BK * 2);
    const size_t hstep = (size_t)HALF * K * 2;
    const size_t tstep = 2 * hstep;
    const unsigned ldsw = (unsigned)wid * 1024u;
    const int aoff = lds_byte(wr * 64 + fr, fq * 8), boff = lds_byte(wc * 32 + fr, fq * 8);
#define PG8_SA(b, h) (((b) * 2 + (h)) * HTB)
#define PG8_SB(b, h) ((4 + (b) * 2 + (h)) * HTB)
#define PG8_STAGE(bufoff, gbase, voff) do { _Pragma("unroll") for (int _i = 0; _i < 2; ++_i) \
        __builtin_amdgcn_global_load_lds((const unsigned*)((const char*)(gbase) + (voff)[_i]), (PG8_LAS unsigned*)(lds + (bufoff) + ldsw + _i * 8192), 16, 0, 0); } while (0)
#define PG8_LDA(dst, b, h) do { _Pragma("unroll") for (int m = 0; m < 4; ++m) _Pragma("unroll") for (int k = 0; k < 2; ++k) dst[m][k] = *(const PG8_LAS bf16x8*)(lds + PG8_SA(b, h) + aoff + m * 2048 + k * 1024); } while (0)
#define PG8_LDB(dst, b, h) do { _Pragma("unroll") for (int n = 0; n < 2; ++n) _Pragma("unroll") for (int k = 0; k < 2; ++k) dst[n][k] = *(const PG8_LAS bf16x8*)(lds + PG8_SB(b, h) + boff + n * 2048 + k * 1024); } while (0)
#define PG8_MMA(ai, bj, At, Bt) do { __builtin_amdgcn_s_setprio(1); _Pragma("unroll") for (int m = 0; m < 4; ++m) _Pragma("unroll") for (int n = 0; n < 2; ++n) _Pragma("unroll") for (int k = 0; k < 2; ++k) \
        acc[ai][bj][m][n] = __builtin_amdgcn_mfma_f32_16x16x32_bf16(Bt[n][k], At[m][k], acc[ai][bj][m][n], 0, 0, 0); __builtin_amdgcn_s_setprio(0); } while (0)
#define PG8_WAIT_V(n) asm volatile("s_waitcnt vmcnt(" #n ")" ::: "memory")
#define PG8_WAIT_L(n) asm volatile("s_waitcnt lgkmcnt(" #n ")" ::: "memory")
#define PG8_BAR __builtin_amdgcn_s_barrier()
#define PG8_SCHED __builtin_amdgcn_sched_barrier(0)
    Unit cur, nxt; int ui = 0;
    if (!S.next(0, cur)) return;
    f32x4 acc[2][2][4][2];
#pragma unroll
    for (int a = 0; a < 2; ++a)
#pragma unroll
        for (int b = 0; b < 2; ++b)
#pragma unroll
            for (int m = 0; m < 4; ++m)
#pragma unroll
                for (int n = 0; n < 2; ++n) acc[a][b][m][n] = (f32x4){0.f, 0.f, 0.f, 0.f};
    bf16x8 At[4][2], B0[2][2], B1[2][2];
    const char* cA = (const char*)g.A + (size_t)cur.pm * tstep; const char* cB = (const char*)g.Bt + (size_t)cur.pn * tstep;
    S.a_ready(cur);
    if constexpr (SP2) {
        PG8_STAGE(PG8_SB(0, 0), cB, voffB); PG8_STAGE(PG8_SB(0, 1), cB + hstep, voffB); PG8_STAGE(PG8_SA(0, 0), cA, voffA); PG8_STAGE(PG8_SA(0, 1), cA + hstep, voffA);
        if (wr == 1) PG8_BAR;
        PG8_WAIT_V(2); PG8_BAR;
        PG8_STAGE(PG8_SB(1, 0), cB + kstep, voffB); PG8_STAGE(PG8_SA(1, 0), cA + kstep, voffA); PG8_STAGE(PG8_SB(1, 1), cB + hstep + kstep, voffB);
        PG8_WAIT_V(6); PG8_BAR;
    } else {
        PG8_STAGE(PG8_SB(0, 0), cB, voffB); PG8_STAGE(PG8_SA(0, 0), cA, voffA); PG8_STAGE(PG8_SB(0, 1), cB + hstep, voffB); PG8_STAGE(PG8_SA(0, 1), cA + hstep, voffA);
        if (wr == 1) PG8_BAR;
        PG8_WAIT_V(4); PG8_BAR;
        PG8_STAGE(PG8_SB(1, 0), cB + kstep, voffB); PG8_STAGE(PG8_SA(1, 0), cA + kstep, voffA); PG8_STAGE(PG8_SB(1, 1), cB + hstep + kstep, voffB);
        PG8_WAIT_V(6); PG8_BAR;
    }
    for (;;) {
        const bool has_next = S.next(ui + 1, nxt);
        const char* nA = has_next ? (const char*)g.A + (size_t)nxt.pm * tstep : cA; const char* nB = has_next ? (const char*)g.Bt + (size_t)nxt.pn * tstep : cB;
        for (int t = 0; t < nt; t += 2) {
            const bool last = (t == nt - 2);
            const char* a1 = cA + (size_t)(t + 1) * kstep;
            const char* a2 = last ? nA : cA + (size_t)(t + 2) * kstep; const char* b2 = last ? nB : cB + (size_t)(t + 2) * kstep;
            const char* a3 = a2 + kstep; const char* b3 = b2 + kstep;
            if (last && has_next) S.a_ready(nxt);
            if constexpr (SP2) {
            PG8_LDB(B0, 0, 0); PG8_LDB(B1, 0, 1); PG8_SCHED; PG8_LDA(At, 0, 0); PG8_STAGE(PG8_SA(1, 1), a1 + hstep, voffA);
            PG8_WAIT_V(8); PG8_WAIT_L(0); PG8_BAR; PG8_MMA(0, 0, At, B0); PG8_MMA(0, 1, At, B1); PG8_BAR; PG8_SCHED;
            PG8_LDA(At, 0, 1); PG8_STAGE(PG8_SB(0, 0), b2, voffB); PG8_STAGE(PG8_SB(0, 1), b2 + hstep, voffB); PG8_STAGE(PG8_SA(0, 0), a2, voffA);
            PG8_WAIT_V(8); PG8_WAIT_L(0); PG8_BAR; PG8_MMA(1, 0, At, B0); PG8_MMA(1, 1, At, B1); PG8_BAR; PG8_SCHED;
            PG8_LDB(B0, 1, 0); PG8_LDB(B1, 1, 1); PG8_SCHED; PG8_LDA(At, 1, 0); PG8_STAGE(PG8_SA(0, 1), a2 + hstep, voffA);
            PG8_WAIT_V(8); PG8_WAIT_L(0); PG8_BAR; PG8_MMA(0, 0, At, B0); PG8_MMA(0, 1, At, B1); PG8_BAR; PG8_SCHED;
            PG8_LDA(At, 1, 1); PG8_STAGE(PG8_SB(1, 0), b3, voffB); PG8_STAGE(PG8_SB(1, 1), b3 + hstep, voffB); PG8_STAGE(PG8_SA(1, 0), a3, voffA);
            PG8_WAIT_V(8); PG8_WAIT_L(0); PG8_BAR; PG8_MMA(1, 0, At, B0); PG8_MMA(1, 1, At, B1); PG8_BAR; PG8_SCHED;
            } else {
            PG8_LDB(B0, 0, 0); PG8_SCHED; PG8_LDA(At, 0, 0); PG8_STAGE(PG8_SA(1, 1), a1 + hstep, voffA);
            PG8_WAIT_L(8); PG8_BAR; PG8_WAIT_L(0); PG8_MMA(0, 0, At, B0); PG8_BAR; PG8_SCHED;
            PG8_LDB(B1, 0, 1); PG8_STAGE(PG8_SB(0, 0), b2, voffB);
            PG8_BAR; PG8_WAIT_L(0); PG8_MMA(0, 1, At, B1); PG8_BAR;
            PG8_LDA(At, 0, 1); PG8_STAGE(PG8_SA(0, 0), a2, voffA);
            PG8_BAR; PG8_WAIT_L(0); PG8_MMA(1, 0, At, B0); PG8_BAR; PG8_SCHED;
            PG8_STAGE(PG8_SB(0, 1), b2 + hstep, voffB);
            PG8_WAIT_V(6); PG8_BAR; PG8_MMA(1, 1, At, B1); PG8_BAR;
            PG8_LDB(B0, 1, 0); PG8_SCHED; PG8_LDA(At, 1, 0); PG8_STAGE(PG8_SA(0, 1), a2 + hstep, voffA);
            PG8_WAIT_L(8); PG8_BAR; PG8_WAIT_L(0); PG8_MMA(0, 0, At, B0); PG8_BAR; PG8_SCHED;
            PG8_LDB(B1, 1, 1); PG8_STAGE(PG8_SB(1, 0), b3, voffB);
            PG8_BAR; PG8_WAIT_L(0); PG8_MMA(0, 1, At, B1); PG8_BAR;
            PG8_LDA(At, 1, 1); PG8_STAGE(PG8_SA(1, 0), a3, voffA);
            PG8_BAR; PG8_WAIT_L(0); PG8_MMA(1, 0, At, B0); PG8_BAR; PG8_SCHED;
            PG8_STAGE(PG8_SB(1, 1), b3 + hstep, voffB);
            PG8_WAIT_V(6); PG8_BAR; PG8_MMA(1, 1, At, B1); PG8_BAR;
            }
        }
        if constexpr (ALIGN_EPI) { if (wr == 0) PG8_BAR; }
        if constexpr (!Epi::AFTER_DRAIN) { E(acc, cur, wr, wc, fr, fq); S.done(cur); }
        if (!has_next) break;
#pragma unroll
        for (int a = 0; a < 2; ++a)
#pragma unroll
            for (int b = 0; b < 2; ++b)
#pragma unroll
                for (int m = 0; m < 4; ++m)
#pragma unroll
                    for (int n = 0; n < 2; ++n) acc[a][b][m][n] = (f32x4){0.f, 0.f, 0.f, 0.f};
        cur = nxt; cA = nA; cB = nB; ++ui;
        if constexpr (ALIGN_EPI) { if (wr == 1) PG8_BAR; }
    }
    PG8_WAIT_V(0);
    if constexpr (!ALIGN_EPI) { if (wr == 0) PG8_BAR; }
    PG8_BAR;
    if constexpr (Epi::AFTER_DRAIN) { E.fused(acc, cur, wr, wc, fr, fq, lds, wid, lane); S.done(cur); }
#undef PG8_SA
#undef PG8_SB
#undef PG8_STAGE
#undef PG8_LDA
#undef PG8_LDB
#undef PG8_MMA
#undef PG8_WAIT_V
#undef PG8_WAIT_L
#undef PG8_BAR
#undef PG8_SCHED
}
}
#include <hip/hip_bf16.h>
namespace att {
using bf16x8 = __attribute__((ext_vector_type(8))) short;
using s16x4 = __attribute__((ext_vector_type(4))) short;
using f32x16 = __attribute__((ext_vector_type(16))) float;
using f32x4 = __attribute__((ext_vector_type(4))) float;
using u32x4 = __attribute__((ext_vector_type(4))) unsigned;
typedef unsigned short bf16_t;
#define ATT_LAS __attribute__((address_space(3)))
typedef ATT_LAS const char* lds_cptr;
typedef short v4i16_t __attribute__((ext_vector_type(4)));
constexpr int SEQ = 4096, NH = 8, QP = 768, KP = 512, RP = 32, VP = 512, GP = 512;
constexpr int KSLOT = 12288, VSLOT = 8192, L_K = 0, L_V = 4 * KSLOT, L_WS = L_V + 3 * VSLOT, ATT_LDS = L_WS + 8 * 256, L_OST = L_K;
__device__ __forceinline__ int crow(int r, int hi) { return (r & 3) + 8 * (r >> 2) + 4 * hi; }
__device__ __forceinline__ void glds16(const void* sbase, unsigned voff, unsigned lds_dst) { unsigned keep;
    asm volatile("s_mov_b32 %0, m0\n\ts_mov_b32 m0, %2\n\ts_nop 4\n\tglobal_load_lds_dwordx4 %1, %3\n\ts_mov_b32 m0, %0" : "=&s"(keep) : "v"(voff), "s"(lds_dst), "s"(sbase) : "memory"); }
__device__ __forceinline__ unsigned cvtpk(float lo, float hi) { typedef float f2 __attribute__((ext_vector_type(2))); typedef __bf16 b2 __attribute__((ext_vector_type(2))); f2 v = {lo, hi}; b2 b = __builtin_convertvector(v, b2); return __builtin_bit_cast(unsigned, b); }
__device__ __forceinline__ float max3f(float a, float b, float c) { float r; asm("v_max3_f32 %0, %1, %2, %3" : "=v"(r) : "v"(a), "v"(b), "v"(c)); return r; }
__device__ __forceinline__ float max2f(float a, float b) { float r; asm("v_max_f32_e32 %0, %1, %2" : "=v"(r) : "v"(a), "v"(b)); return r; }
__device__ __forceinline__ float fadd_s(float a, float b) { float r; asm("v_add_f32_e32 %0, %1, %2" : "=v"(r) : "v"(a), "v"(b)); return r; }
__device__ __forceinline__ float fsub_s(float a, float b) { float r; asm("v_sub_f32_e32 %0, %1, %2" : "=v"(r) : "v"(a), "v"(b)); return r; }
#define SBAR() __builtin_amdgcn_sched_barrier(0)
#define WAIT_BAR(N) asm volatile("s_waitcnt vmcnt(" #N ") lgkmcnt(0)\n\ts_barrier" ::: "memory")
#define MFMA32(a, b, c) __builtin_amdgcn_mfma_f32_32x32x16_bf16(a, b, c, 0, 0, 0)
__device__ __forceinline__ void cmask(f32x16& p0, f32x16& p1, int jb, int qrel, int hi) {
    const float NEG = -INFINITY; const int kb = 64 * jb + 4 * hi;
#pragma unroll
    for (int r = 0; r < 16; ++r) { const int kv = kb + (r & 3) + 8 * (r >> 2); if (kv > qrel) p0[r] = NEG; if (kv + 32 > qrel) p1[r] = NEG; } }
__device__ __forceinline__ void kload2(bf16x8* kf, lds_cptr kp, int j) { kf[2 * j] = *(const ATT_LAS bf16x8*)(kp + j * 2048); kf[2 * j + 1] = *(const ATT_LAS bf16x8*)(kp + j * 2048 + 512); }
__device__ __forceinline__ s16x4 vtr(lds_cptr p) { return __builtin_bit_cast(s16x4, __builtin_amdgcn_ds_read_tr16_b64_v4i16((ATT_LAS v4i16_t*)p)); }
__device__ __forceinline__ float rowmax(const f32x16& p0, const f32x16& p1) {
    float a = max3f(p0[0], p0[1], p1[0]), b = max3f(p0[2], p0[3], p1[1]); a = max3f(a, p1[2], p1[3]);
#pragma unroll
    for (int r = 4; r < 16; r += 4) { a = max3f(a, p0[r], p0[r + 1]); b = max3f(b, p0[r + 2], p0[r + 3]); a = max3f(a, p1[r], p1[r + 1]); b = max3f(b, p1[r + 2], p1[r + 3]); }
    const float m = max2f(a, b); auto rr = __builtin_amdgcn_permlane32_swap(__float_as_uint(m), __float_as_uint(m), false, false);
    return max2f(__uint_as_float(rr[0]), __uint_as_float(rr[1])); }
__device__ __forceinline__ void pv(f32x16* o, unsigned vb, bf16x8 pa0, bf16x8 pa1, bf16x8 pa2, bf16x8 pa3) {
#pragma unroll
    for (int d0 = 0; d0 < 2; ++d0) { s16x4 lo[4], hh[4];
#pragma unroll
        for (int ks = 0; ks < 4; ++ks) {
            asm volatile("ds_read_b64_tr_b16 %0,%1 offset:%c2" : "=&v"(lo[ks]) : "v"(vb), "i"(d0 * 4096 + ks * 1024) : "memory");
            asm volatile("ds_read_b64_tr_b16 %0,%1 offset:%c2" : "=&v"(hh[ks]) : "v"(vb), "i"(d0 * 4096 + ks * 1024 + 512) : "memory"); }
        asm volatile("s_waitcnt lgkmcnt(0)" ::: "memory"); SBAR();
#define ATT_PK(k) (bf16x8){lo[k][0], lo[k][1], lo[k][2], lo[k][3], hh[k][0], hh[k][1], hh[k][2], hh[k][3]}
        o[d0] = MFMA32(pa0, ATT_PK(0), o[d0]); o[d0] = MFMA32(pa1, ATT_PK(1), o[d0]); o[d0] = MFMA32(pa2, ATT_PK(2), o[d0]); o[d0] = MFMA32(pa3, ATT_PK(3), o[d0]);
#undef ATT_PK
    }
}

template <int THRL> __device__ __forceinline__ void attn_unit(int b, int h, int qb, const bf16_t* Q, const bf16_t* KN, const bf16_t* KR, const bf16_t* V, const bf16_t* SG, bf16_t* OG, ATT_LAS unsigned char* lds) {
    const int tid = threadIdx.x, lane = tid & 63, r32 = lane & 31, hi = lane >> 5; const int wid = __builtin_amdgcn_readfirstlane(tid >> 6);
    const long rowbase = (long)b * SEQ; const int q0 = qb * 256, NT = (q0 + 256) / 64;
    const bf16_t* Qw = Q + (rowbase + q0 + wid * 32) * QP + h * 96;
    const bf16_t* kb0 = KN + rowbase * KP + h * 64 + wid * 8; const unsigned ko0 = (unsigned)lane * (KP * 2);
    const bf16_t* kb1 = KR + rowbase * RP + (wid & 3) * 8;    const unsigned ko1 = (unsigned)lane * (RP * 2);
    const bf16_t* vbs = V + (rowbase + 16 * (wid & 3)) * VP + h * 64 + (wid >> 2) * 32; const unsigned vo = (unsigned)(lane >> 2) * (VP * 2) + (lane & 3) * 16;
    const unsigned lds0 = (unsigned)(uintptr_t)lds;
    const unsigned kdst0 = lds0 + L_K + wid * 1024, kdst1 = lds0 + L_K + (8 + (wid & 3)) * 1024, vdst = lds0 + L_V + wid * 1024;
#define DMA_K(t, slot) do { glds16(kb0 + (long)(t) * 64 * KP, ko0, (unsigned)__builtin_amdgcn_readfirstlane(kdst0 + (slot))); glds16(kb1 + (long)(t) * 64 * RP, ko1, (unsigned)__builtin_amdgcn_readfirstlane(kdst1 + (slot))); } while (0)
#define DMA_V(t, slot) glds16(vbs + (long)(t) * 64 * VP, vo, (unsigned)__builtin_amdgcn_readfirstlane(vdst + (slot)))
    ATT_LAS float* wsf = (ATT_LAS float*)(lds + L_WS) + wid * 64;
    const ATT_LAS float* wsh = wsf + 4 * hi;
#define CR(r) (((r) & 3) + 8 * ((r) >> 2))
    const lds_cptr lds3 = (lds_cptr)lds;
    const lds_cptr kp0 = lds3 + L_K + hi * 1024 + r32 * 16;
    const lds_cptr vp0 = lds3 + L_V + ((lane >> 4) & 1) * 32 + (lane & 3) * 8 + (4 * hi + ((lane & 15) >> 2)) * 64;
    const unsigned vb0 = lds0 + L_V + ((lane >> 4) & 1) * 32 + (lane & 3) * 8 + (4 * hi + ((lane & 15) >> 2)) * 64;
    DMA_K(0, 0); DMA_V(0, 0); DMA_K(1, KSLOT);
    bf16x8 qr[6];
#pragma unroll
    for (int d0 = 0; d0 < 6; ++d0) qr[d0] = *reinterpret_cast<const bf16x8*>(&Qw[(long)r32 * QP + d0 * 16 + hi * 8]);
    float mhat = 0.f, l_reg = 0.f; f32x16 o[2]; o[0] = f32x16{}; o[1] = f32x16{}; f32x16 negm = f32x16{}; asm volatile("" : "+v"(negm));
    const int qrel = wid * 32 + r32;
#define CMASK(P0, P1, t) do { int jb_ = (t) - (NT - 4); if (jb_ >= 0) cmask(P0, P1, jb_, qrel, hi); } while (0)
    bool resc = false;
#define START(P0, P1) do { const float rm = rowmax(P0, P1); resc = false; \
    { const float dl = rm; mhat = fadd_s(mhat, dl); \
      _Pragma("unroll") for (int r = 0; r < 16; ++r) { P0[r] = fsub_s(P0[r], dl); P1[r] = fsub_s(P1[r], dl); } \
      _Pragma("unroll") for (int r = 0; r < 16; ++r) negm[r] = -mhat; asm volatile("" : "+v"(negm)); } \
    _Pragma("unroll") for (int r = 0; r < 16; ++r) P0[r] = __builtin_amdgcn_exp2f(P0[r]); } while (0)
#define RESC() do { if (resc) { asm volatile("s_waitcnt lgkmcnt(0)" ::: "memory"); \
      _Pragma("unroll") for (int d_ = 0; d_ < 2; ++d_) _Pragma("unroll") for (int r = 0; r < 16; ++r) o[d_][r] *= wsh[CR(r)]; } } while (0)
    f32x16 pA0, pA1, pB0, pB1; bf16x8 kq[12];
    int sv_prev = 0, sv_cur = 0, sv_next = VSLOT;
#define ROT() do { sv_prev = sv_cur; sv_cur = sv_next; sv_next = (sv_next == 2 * VSLOT) ? 0 : sv_next + VSLOT; } while (0)
#define KLDF(i, kp) kq[i] = *(const ATT_LAS bf16x8*)((kp) + ((i) >> 1) * 2048 + ((i) & 1) * 512)
    DMA_K(2, 2 * KSLOT);
    WAIT_BAR(5);
    { pA0 = negm; pA1 = negm;
#pragma unroll
      for (int d0 = 0; d0 < 6; ++d0) { const bf16x8 b0 = *(const ATT_LAS bf16x8*)(kp0 + d0 * 2048), b1 = *(const ATT_LAS bf16x8*)(kp0 + d0 * 2048 + 512);
          pA0 = MFMA32(b0, qr[d0], pA0); pA1 = MFMA32(b1, qr[d0], pA1); } }
    asm volatile("s_nop 15\n\ts_nop 7" : "+v"(pA0), "+v"(pA1)); CMASK(pA0, pA1, 0);
    START(pA0, pA1);
#pragma unroll
    for (int r = 0; r < 16; ++r) pA1[r] = __builtin_amdgcn_exp2f(pA1[r]);
    WAIT_BAR(0);
    DMA_K(3, 3 * KSLOT); DMA_V(1, VSLOT);
    ROT();
    KLDF(0, kp0 + KSLOT); KLDF(1, kp0 + KSLOT); KLDF(2, kp0 + KSLOT); KLDF(3, kp0 + KSLOT);
    s16x4 vl[4], vh[4]; u32x4 pw0, pw1, pw2, pw3;
#define PKW(P, B) cvtpk(P[B], P[B + 1])
#define PAF(k) __builtin_bit_cast(bf16x8, pw##k)
#define VFR(i) (bf16x8){vl[i][0], vl[i][1], vl[i][2], vl[i][3], vh[i][0], vh[i][1], vh[i][2], vh[i][3]}
#define PIN(x) asm volatile("" : "+v"(x))
#define MX3(a, b, c) __builtin_fmaxf(__builtin_fmaxf((a), (b)), (c))
#define GA3(MF, A0, A1, A2, W0, PW) do { MF; sacc += A0; sacc += A1; sacc += A2; PIN(sacc); W0; PIN(PW); SBAR(); } while (0)
#define GA2(MF, A0, A1, W0, W1, PW) do { MF; sacc += A0; sacc += A1; PIN(sacc); W0; W1; PIN(PW); SBAR(); } while (0)
#define GA1(MF, A0, A1, W0, PW) do { MF; sacc += A0; sacc += A1; PIN(sacc); W0; PIN(PW); SBAR(); } while (0)
#define EX(v) __builtin_amdgcn_exp2f(v)
#define GAPB(MF, X, B) do { MF; X[B] = EX(X[B]); X[B + 1] = EX(X[B + 1]); X[B + 2] = EX(X[B + 2]); X[B + 3] = EX(X[B + 3]); PIN(X); SBAR(); } while (0)
#define VRD(s_, i) do { vl[s_] = vtr(vp_ + (((i) >> 2) * 4096 + ((i) & 3) * 1024)); vh[s_] = vtr(vp_ + (((i) >> 2) * 4096 + ((i) & 3) * 1024 + 512)); } while (0)
#define KPF(G, i) do { if (G) { KLDF(i, kn_); } } while (0)
#define STEP(C0, C1, P0, P1, t, GK, GV, GL) do { SBAR(); \
    const lds_cptr vp_ = vp0 + sv_prev; const lds_cptr kc_ = kp0 + ((t) & 3) * KSLOT; const lds_cptr kn_ = kp0 + (((t) + 1) & 3) * KSLOT; \
    KLDF(4, kc_); SBAR(); float sacc = (P0[0] + P0[1]); \
    GA3(C0 = MFMA32(kq[0], qr[0], negm), P0[2], P0[3], P0[4],    pw0[0] = PKW(P0, 0), pw0); \
    KLDF(5, kc_); SBAR(); GA3(C1 = MFMA32(kq[1], qr[0], negm), P0[5], P0[6], P0[7],    pw0[1] = PKW(P0, 2), pw0); \
    KLDF(6, kc_); SBAR(); GA3(C0 = MFMA32(kq[2], qr[1], C0),   P0[8], P0[9], P0[10],   pw0[2] = PKW(P0, 4), pw0); \
    KLDF(7, kc_); SBAR(); GA3(C1 = MFMA32(kq[3], qr[1], C1),   P0[11], P0[12], P0[13], pw0[3] = PKW(P0, 6), pw0); \
    KLDF(8, kc_); SBAR(); GA3(C0 = MFMA32(kq[4], qr[2], C0),   P0[14], P0[15], P1[0],  pw1[0] = PKW(P0, 8), pw1); \
    KLDF(9, kc_); SBAR(); GA3(C1 = MFMA32(kq[5], qr[2], C1),   P1[1], P1[2], P1[3],    pw1[1] = PKW(P0, 10), pw1); \
    KLDF(10, kc_); SBAR(); GA2(C0 = MFMA32(kq[6], qr[3], C0),  P1[4], P1[5],   pw1[2] = PKW(P0, 12), pw1[3] = PKW(P0, 14), pw1); \
    KLDF(11, kc_); SBAR(); GA2(C1 = MFMA32(kq[7], qr[3], C1),  P1[6], P1[7],   pw2[0] = PKW(P1, 0), pw2[1] = PKW(P1, 2), pw2); \
    VRD(0, 0); SBAR(); GA2(C0 = MFMA32(kq[8], qr[4], C0),   P1[8], P1[9],   pw2[2] = PKW(P1, 4), pw2[3] = PKW(P1, 6), pw2); \
    VRD(1, 4); SBAR(); GA2(C1 = MFMA32(kq[9], qr[4], C1),   P1[10], P1[11], pw3[0] = PKW(P1, 8), pw3[1] = PKW(P1, 10), pw3); \
    VRD(2, 1); SBAR(); GA1(C0 = MFMA32(kq[10], qr[5], C0),  P1[12], P1[13], pw3[2] = PKW(P1, 12), pw3); \
    VRD(3, 5); SBAR(); GA1(C1 = MFMA32(kq[11], qr[5], C1),  P1[14], P1[15], pw3[3] = PKW(P1, 14), pw3); \
    l_reg += sacc; \
    if (GK) { DMA_K((t) + 3, (((t) + 3) & 3) * KSLOT); } if (GV) { DMA_V((t) + 1, sv_next); } \
    CMASK(C0, C1, t); \
    { float a = MX3(C0[0], C0[1], C1[0]), b = MX3(C0[2], C0[3], C1[1]); a = MX3(a, C1[2], C1[3]); \
      _Pragma("unroll") for (int r = 4; r < 16; r += 4) { a = MX3(a, C0[r], C0[r + 1]); b = MX3(b, C0[r + 2], C0[r + 3]); a = MX3(a, C1[r], C1[r + 1]); b = MX3(b, C1[r + 2], C1[r + 3]); } \
      float rm = __builtin_fmaxf(a, b); { auto rr = __builtin_amdgcn_permlane32_swap(__float_as_uint(rm), __float_as_uint(rm), false, false); rm = __builtin_fmaxf(__uint_as_float(rr[0]), __uint_as_float(rr[1])); } \
      resc = false; \
      if (__builtin_expect(__any(rm > (float)THRL), 0)) { const float dl = __builtin_fmaxf(rm, 0.f); mhat += dl; \
        _Pragma("unroll") for (int r = 0; r < 16; ++r) { C0[r] -= dl; C1[r] -= dl; } \
        _Pragma("unroll") for (int r = 0; r < 16; ++r) negm[r] = -mhat; asm volatile("" : "+v"(negm)); \
        const float f = __builtin_amdgcn_exp2f(-dl); l_reg *= f; if (hi == 0) wsf[r32] = f; resc = true; } } \
    SBAR(); \
    GAPB(o[0] = MFMA32(PAF(0), VFR(0), o[0]), C0, 0); \
    VRD(0, 2); SBAR(); GAPB(o[1] = MFMA32(PAF(0), VFR(1), o[1]), C0, 4); \
    VRD(1, 6); SBAR(); GAPB(o[0] = MFMA32(PAF(1), VFR(2), o[0]), C0, 8); \
    VRD(2, 3); SBAR(); GAPB(o[1] = MFMA32(PAF(1), VFR(3), o[1]), C0, 12); \
    VRD(3, 7); KPF(GL, 0); SBAR(); GAPB(o[0] = MFMA32(PAF(2), VFR(0), o[0]), C1, 0); \
    KPF(GL, 1); SBAR(); GAPB(o[1] = MFMA32(PAF(2), VFR(1), o[1]), C1, 4); \
    KPF(GL, 2); SBAR(); GAPB(o[0] = MFMA32(PAF(3), VFR(2), o[0]), C1, 8); \
    KPF(GL, 3); SBAR(); GAPB(o[1] = MFMA32(PAF(3), VFR(3), o[1]), C1, 12); \
    } while (0)
    int t = 1;
#undef CMASK
#define CMASK(P0, P1, t) do {} while (0)
    for (; t + 5 < NT; t += 2) {
        STEP(pB0, pB1, pA0, pA1, t, true, true, true);       WAIT_BAR(3); RESC(); ROT();
        STEP(pA0, pA1, pB0, pB1, t + 1, true, true, true);   WAIT_BAR(3); RESC(); ROT();
    }
#undef CMASK
#define CMASK(P0, P1, t) do { int jb_ = (t) - (NT - 4); if (jb_ >= 0) cmask(P0, P1, jb_, qrel, hi); } while (0)
#define ENDW(tt) do { if ((tt) + 3 < NT) { WAIT_BAR(3); } else if ((tt) + 2 < NT) { WAIT_BAR(1); } else { WAIT_BAR(0); } } while (0)
    for (; t + 1 < NT; t += 2) {
        STEP(pB0, pB1, pA0, pA1, t, (t + 3 < NT), (t + 1 < NT), (t + 1 < NT));         ENDW(t);     RESC(); ROT();
        STEP(pA0, pA1, pB0, pB1, t + 1, (t + 4 < NT), (t + 2 < NT), (t + 2 < NT));     ENDW(t + 1); RESC(); ROT();
    }
    STEP(pB0, pB1, pA0, pA1, NT - 1, false, false, false); RESC();
    { float sacc = pB0[0] + pB0[1];
#pragma unroll
      for (int r = 2; r < 16; ++r) sacc += pB0[r];
#pragma unroll
      for (int r = 0; r < 16; ++r) sacc += pB1[r];
      l_reg += sacc;
      pw0 = (u32x4){PKW(pB0, 0), PKW(pB0, 2), PKW(pB0, 4), PKW(pB0, 6)}; pw1 = (u32x4){PKW(pB0, 8), PKW(pB0, 10), PKW(pB0, 12), PKW(pB0, 14)};
      pw2 = (u32x4){PKW(pB1, 0), PKW(pB1, 2), PKW(pB1, 4), PKW(pB1, 6)}; pw3 = (u32x4){PKW(pB1, 8), PKW(pB1, 10), PKW(pB1, 12), PKW(pB1, 14)};
      SBAR(); pv(o, vb0 + sv_cur, PAF(0), PAF(1), PAF(2), PAF(3)); }
#undef PKW
#undef PAF
#undef VFR
#undef PIN
#undef MX3
#undef GA3
#undef GA2
#undef GA1
#undef GAPB
#undef EX
#undef VRD
#undef KPF
#undef KLDF
#undef STEP
#undef ENDW
    { auto rr = __builtin_amdgcn_permlane32_swap(__float_as_uint(l_reg), __float_as_uint(l_reg), false, false); l_reg = __uint_as_float(rr[0]) + __uint_as_float(rr[1]); }
    if (hi == 0) wsf[32 + r32] = __builtin_amdgcn_rcpf(l_reg);
    asm volatile("s_waitcnt lgkmcnt(0)" ::: "memory");
    ATT_LAS bf16_t* stg = (ATT_LAS bf16_t*)(lds + L_OST) + wid * 2048;
    { const bf16_t* sgp = SG + (rowbase + q0 + wid * 32 + 4 * hi) * GP + h * 64 + r32; ATT_LAS bf16_t* stl = stg + 4 * hi * 64 + r32;
#pragma unroll
      for (int r = 0; r < 16; ++r) { const float rl = wsh[32 + CR(r)];
          const float g0 = __uint_as_float((unsigned)sgp[CR(r) * GP] << 16), g1 = __uint_as_float((unsigned)sgp[CR(r) * GP + 32] << 16);
          const unsigned w = cvtpk(o[0][r] * rl * g0, o[1][r] * rl * g1);
          stl[CR(r) * 64] = (bf16_t)(w & 0xffffu); stl[CR(r) * 64 + 32] = (bf16_t)(w >> 16); } }
    asm volatile("s_waitcnt lgkmcnt(0)" ::: "memory");
#pragma unroll
    for (int i = 0; i < 4; ++i) { const int row = i * 8 + (lane >> 3), ch = lane & 7; const long grow = rowbase + q0 + wid * 32 + row;
        *(u32x4*)(OG + grow * GP + h * 64 + ch * 8) = *(const ATT_LAS u32x4*)(stg + row * 64 + ch * 8); }
    asm volatile("s_waitcnt lgkmcnt(0)\n\ts_barrier" ::: "memory");
#undef DMA_K
#undef DMA_V
#undef CMASK
#undef START
#undef RESC
#undef ROT
#undef CR
}
#undef SBAR
#undef WAIT_BAR
#undef MFMA32
}
#define GAS __attribute__((address_space(1)))
#define LAS __attribute__((address_space(3)))
typedef unsigned short bf16;
typedef unsigned v4u __attribute__((ext_vector_type(4)));
typedef float f32x4 __attribute__((ext_vector_type(4)));
typedef short bf16x8 __attribute__((ext_vector_type(8)));
typedef GAS unsigned gu32;
typedef GAS unsigned long long gu64;
#define RLX_AGENT __ATOMIC_RELAXED, __HIP_MEMORY_SCOPE_AGENT
#define LDS_WAIT() asm volatile("s_waitcnt lgkmcnt(0)" ::: "memory")
#define VM_WAIT() asm volatile("s_waitcnt vmcnt(0)" ::: "memory")
__device__ __forceinline__ unsigned long long rt() { return __builtin_amdgcn_s_memrealtime(); }
__device__ __forceinline__ unsigned f2bf(float f) { unsigned u = __builtin_bit_cast(unsigned, f); return (u + 0x7fffu + ((u >> 16) & 1u)) >> 16; }
__device__ __forceinline__ unsigned pk2(float lo, float hi) { return f2bf(lo) | (f2bf(hi) << 16); }

#define XB_TMO      128
#define XB_XCNT(j)  (256  + 64 * (j))
#define XB_XSUB(j)  (1280 + 64 * (j))
#define XB_XGEN(j)  (2304 + 64 * (j))
#define XB_TOP      3328
#define XB_TOPGEN   3392
#define XCD_BAR_WORDS 3456
#define XB_SPIN_CAP (1u << 18)

__device__ __forceinline__ unsigned xb_ld(unsigned* p)              { return __hip_atomic_load(p, __ATOMIC_RELAXED, __HIP_MEMORY_SCOPE_AGENT); }
__device__ __forceinline__ unsigned xb_add(unsigned* p, unsigned v) { return __hip_atomic_fetch_add(p, v, __ATOMIC_RELAXED, __HIP_MEMORY_SCOPE_AGENT); }
__device__ __forceinline__ unsigned xb_xcc_id() { return (unsigned)__builtin_amdgcn_s_getreg((3 << 11) | 20) & 0xFu; }
#define XB_SPIN(cond, bar) do { unsigned _sp = 0; while (cond) { __builtin_amdgcn_s_sleep(1); \
    if ((++_sp & 255u) == 0u) { if (xb_ld(&(bar)[XB_TMO])) break; if (_sp > XB_SPIN_CAP) { atomicAdd(&(bar)[XB_TMO], 1u); break; } } } } while (0)

struct XcdBarrier {
    unsigned* bar; unsigned x;
    volatile LAS unsigned* st;
};

__device__ __forceinline__ XcdBarrier xcd_barrier_post(unsigned* bar, volatile LAS unsigned* st) {
    XcdBarrier b; b.bar = bar; b.x = xb_xcc_id(); b.st = st;
    if (threadIdx.x == 0) (void)xb_add(&bar[XB_XCNT(b.x)], 1u);
    return b;
}
__device__ __forceinline__ void xcd_barrier_complete(unsigned* bar, unsigned x, unsigned& nloc, unsigned& nx) {
    const unsigned G = gridDim.x * gridDim.y * gridDim.z;
    unsigned sum, cnt, mine, sp = 0u;
    for (;;) {
        sum = 0u; cnt = 0u; mine = 0u;
#pragma unroll
        for (unsigned j = 0; j < 16; ++j) { const unsigned c = xb_ld(&bar[XB_XCNT(j)]); sum += c; cnt += (c > 0u) ? 1u : 0u; mine = (j == x) ? c : mine; }
        if (sum == G) break;
        __builtin_amdgcn_s_sleep(1);
        if ((++sp & 255u) == 0u) { if (xb_ld(&bar[XB_TMO])) break; if (sp > XB_SPIN_CAP) { atomicAdd(&bar[XB_TMO], 1u); break; } }
    }
    nloc = mine > 0u ? mine : 1u; nx = cnt > 0u ? cnt : 1u;
}

__device__ __forceinline__ void xcd_barrier(const XcdBarrier& b) {
    asm volatile("s_waitcnt vmcnt(0)" ::: "memory");
    __syncthreads();
    if (threadIdx.x == 0) {
        unsigned* bar = b.bar;
        __builtin_amdgcn_s_waitcnt(0);
        unsigned nloc = b.st[0], nx = b.st[1];
        if (nloc == 0u) { xcd_barrier_complete(bar, b.x, nloc, nx); b.st[0] = nloc; b.st[1] = nx; }
        const unsigned old = xb_add(&bar[XB_XSUB(b.x)], 1u);
        const unsigned gen = old / nloc;
        if (old + 1u == (gen + 1u) * nloc) {
            __builtin_amdgcn_fence(__ATOMIC_RELEASE, "agent");
            asm volatile("s_waitcnt vmcnt(0)" ::: "memory");
            const unsigned og = xb_add(&bar[XB_TOP], 1u);
            const unsigned tg = og / nx;
            if (og + 1u == (tg + 1u) * nx) xb_add(&bar[XB_TOPGEN], 1u);
            else XB_SPIN(xb_ld(&bar[XB_TOPGEN]) == tg, bar);
            __builtin_amdgcn_fence(__ATOMIC_ACQUIRE, "agent");
            xb_add(&bar[XB_XGEN(b.x)], 1u);
            asm volatile("s_waitcnt vmcnt(0)" ::: "memory");
        } else {
            XB_SPIN(xb_ld(&bar[XB_XGEN(b.x)]) == gen, bar);
            __builtin_amdgcn_fence(__ATOMIC_ACQUIRE, "agent");
            asm volatile("s_waitcnt vmcnt(0)" ::: "memory");
        }
    }
    __syncthreads();
}

constexpr int NWAVES = 8;
#ifndef MK_N_LAUNCHES
#define MK_N_LAUNCHES 1
#endif
constexpr int N_PHASES = 9;
constexpr int TOK = 65536, DM = 1024, SEQ = 4096;
constexpr float EPS = 1e-6f;
constexpr float C2 = 0.10206207261596577f * 1.4426950408889634f;
constexpr size_t MiB = 1u << 20;
constexpr size_t WS_CTL = 0, CTL_ZERO_BYTES = 1 * MiB;
constexpr size_t WS_W1 = 2 * MiB;
constexpr size_t WS_W2 = 10 * MiB;
constexpr size_t WS_W3 = 12 * MiB;
constexpr size_t WS_W4A = 15 * MiB;
constexpr size_t WS_W4B = 16 * MiB;
constexpr size_t WS_W5 = 17 * MiB;
constexpr size_t WS_R0 = 18 * MiB;
constexpr size_t WS_SS1 = 19 * MiB;
constexpr size_t WS_SS2 = 23 * MiB;
constexpr size_t WS_SSKV = 27 * MiB;
constexpr size_t WS_SSQ = 28 * MiB;
constexpr size_t WS_CS = 30 * MiB;
constexpr size_t WS_XB = 64 * MiB;
constexpr size_t WS_VG = 192 * MiB;
constexpr size_t WS_Y = 448 * MiB;
constexpr size_t WS_CKV = 576 * MiB;
constexpr size_t WS_CQ = 608 * MiB;
constexpr size_t WS_KR = 656 * MiB;
constexpr size_t WS_SG = 660 * MiB;
constexpr size_t WS_KN = 724 * MiB;
constexpr size_t WS_VB = 788 * MiB;
constexpr size_t WS_QB = 852 * MiB;
constexpr size_t WS_OG = 948 * MiB;
constexpr size_t WS_X1B = WS_VG;
constexpr size_t WS_END = 1012 * MiB;
constexpr int CW_TMO = 0, CW_BAR = 4096;
constexpr int RING_OFF = 0, RING_BYTES = 131072, LDSCTL_OFF = RING_BYTES, MISC_OFF = LDSCTL_OFF + 320, LDS_BYTES = 147456;
static_assert(att::ATT_LDS <= RING_BYTES, "attention scratch inside the ring region");

struct Args { const float* in[16]; float* out; unsigned char* ws; int ph_lo, ph_hi, li, pad; };

__device__ __forceinline__ float wave_sum(float v) {
#pragma unroll
    for (int o = 1; o < 64; o <<= 1) v += __shfl_xor(v, o);
    return v;
}
__device__ __forceinline__ int lc_of(int cp) { return (cp & ~0x1C) | (((cp >> 2) & 3) << 3) | (((cp >> 4) & 1) << 2); }
__device__ __forceinline__ void wmap(const Args& A, int gemm, int wrow, const float*& W, int& ld, int& col, const float*& gain) {
    const int pn = wrow >> 8, cp = wrow & 255, L = (pn << 8) + lc_of(cp);
    switch (gemm) {
    case 0: { const int bj = cp >> 7, wc = (cp >> 5) & 3, n = (cp >> 4) & 1, fq = (cp >> 2) & 3, e = cp & 3; W = A.in[3]; ld = 4096; col = 1024 * (2 * bj + n) + 64 * pn + 16 * wc + 4 * fq + e; gain = A.in[2]; } break;
    case 1: W = A.in[5]; ld = 1024; col = L; gain = nullptr; break;
    case 2: if (L < 256) { W = A.in[7]; ld = 288; col = L; gain = A.in[6]; }
            else if (L < 640) { W = A.in[11]; ld = 896; col = L - 256; gain = A.in[10]; }
            else if (L < 768) { const int p = L - 640; W = A.in[7]; ld = 288; gain = A.in[6]; col = (p < 32) ? 256 + 4 * (p >> 3) + (p & 3) + 16 * ((p >> 2) & 1) : -1; }
            else { W = A.in[11]; ld = 896; col = 384 + (L - 768); gain = A.in[10]; } break;
    case 3: W = A.in[9]; ld = 1024; gain = A.in[8]; col = (L < 512) ? (L >> 6) * 128 + (L & 63) : ((L - 512) >> 6) * 128 + 64 + (L & 63); break;
    case 4: { const int h = L / 96, d = L % 96; W = A.in[13]; ld = 768; gain = A.in[12]; if (d < 64) col = h * 96 + d; else { const int p = d - 64; col = h * 96 + 64 + 4 * (p >> 3) + (p & 3) + 16 * ((p >> 2) & 1); } } break;
    default: W = A.in[14]; ld = 1024; col = L; gain = nullptr; break;
    }
}
__device__ __forceinline__ void prep_item(const Args& A, int gemm, int K, bf16* WT, LAS float* scr, int item, int lane) {
    const int nblk_k = K / 64, nb = item / nblk_k, kb = item % nblk_k, k0 = 64 * kb, n0 = 32 * nb;
    const float* W; int ld, col; const float* gain; wmap(A, gemm, n0 + (lane & 31), W, ld, col, gain);
#pragma unroll 8
    for (int i = 0; i < 32; ++i) { const int kk = 2 * i + (lane >> 5); float v = 0.f; if (col >= 0) { v = W[(size_t)(k0 + kk) * ld + col]; if (gain) v *= gain[k0 + kk]; } scr[kk * 33 + (lane & 31)] = v; }
    LDS_WAIT(); asm volatile("" ::: "memory");
    const int c = lane & 7;
#pragma unroll
    for (int j = 0; j < 4; ++j) { const int n = (lane >> 3) + 8 * j; const LAS float* s = scr + (8 * c) * 33 + n;
        v4u o; o.x = pk2(s[0 * 33], s[1 * 33]); o.y = pk2(s[2 * 33], s[3 * 33]); o.z = pk2(s[4 * 33], s[5 * 33]); o.w = pk2(s[6 * 33], s[7 * 33]);
        *(GAS v4u*)(WT + (size_t)(n0 + n) * K + k0 + 8 * c) = o; }
    LDS_WAIT(); asm volatile("" ::: "memory");
}

__global__ void __launch_bounds__(NWAVES * 64, 2) yoco_fwd(Args args) {
    extern __shared__ __attribute__((aligned(16))) unsigned char lds_raw[];
    LAS unsigned char* lds = (LAS unsigned char*)lds_raw;
    volatile LAS unsigned* MISC = (volatile LAS unsigned*)(lds + MISC_OFF);
    const int tid = threadIdx.x, lane = tid & 63, wave = __builtin_amdgcn_readfirstlane(tid >> 6);
    const int G = gridDim.x, bx = blockIdx.x, vcu = (G % 8 == 0) ? (bx % 8) * (G / 8) + bx / 8 : bx;
    unsigned char* ws = args.ws;
    gu32* ctl = (gu32*)(ws + WS_CTL);
    bf16 *W1 = (bf16*)(ws + WS_W1), *W2 = (bf16*)(ws + WS_W2), *W3 = (bf16*)(ws + WS_W3), *W4A = (bf16*)(ws + WS_W4A), *W4B = (bf16*)(ws + WS_W4B), *W5 = (bf16*)(ws + WS_W5);
    float *R0 = (float*)(ws + WS_R0), *SS1 = (float*)(ws + WS_SS1), *SS2 = (float*)(ws + WS_SS2), *SSKV = (float*)(ws + WS_SSKV), *SSQ = (float*)(ws + WS_SSQ), *CS = (float*)(ws + WS_CS);
    bf16 *XB = (bf16*)(ws + WS_XB), *VG = (bf16*)(ws + WS_VG), *Y = (bf16*)(ws + WS_Y), *CKV = (bf16*)(ws + WS_CKV), *CQ = (bf16*)(ws + WS_CQ), *KR = (bf16*)(ws + WS_KR),
         *SG = (bf16*)(ws + WS_SG), *OG = (bf16*)(ws + WS_OG), *X1B = (bf16*)(ws + WS_X1B), *KN = (bf16*)(ws + WS_KN), *VB = (bf16*)(ws + WS_VB), *QB = (bf16*)(ws + WS_QB);
    for (int u = tid; u < (LDS_BYTES - LDSCTL_OFF) / 4; u += NWAVES * 64) ((LAS unsigned*)(lds + LDSCTL_OFF))[u] = 0u;
    __syncthreads();
    XcdBarrier bar = xcd_barrier_post((unsigned*)(ctl + CW_BAR) + args.li * XCD_BAR_WORDS, MISC + 8);
    const int lo = args.ph_lo, hi = args.ph_hi;
#ifndef PROBE_REPEAT
#define PROBE_REPEAT -1
#endif
#define IN(k) (lo <= (k) && (k) < hi)
#define RPT(k) for (int rpt_ = 0; rpt_ < ((PROBE_REPEAT) == (k) ? 2 : 1); ++rpt_)
#define SEAM(k) do { if (IN(k) && IN((k) + 1)) xcd_barrier(bar); } while (0)
    const int gw = vcu * NWAVES + wave, NGW = G * NWAVES, gt = vcu * NWAVES * 64 + tid, NGT = G * NWAVES * 64;

    if (IN(0)) RPT(0) {
        LAS float* scr = (LAS float*)(lds + RING_OFF + wave * 16384);
        constexpr int I0 = 16 * 128, I1 = 16 * 32, I2 = 16 * 40, I3 = 4 * 32, I4 = 6 * 24, I5 = 8 * 32, NITEMS = I0 + I1 + I2 + I3 + I4 + I5;
        for (int it = gw; it < NITEMS; it += NGW) { int r = it;
            if (r < I0) { prep_item(args, 0, 1024, W1, scr, r, lane); continue; } r -= I0;
            if (r < I1) { prep_item(args, 1, 1024, W2, scr, r, lane); continue; } r -= I1;
            if (r < I2) { prep_item(args, 2, 1024, W3, scr, r, lane); continue; } r -= I2;
            if (r < I3) { prep_item(args, 3, 256, W4A, scr, r, lane); continue; } r -= I3;
            if (r < I4) { prep_item(args, 4, 384, W4B, scr, r, lane); continue; } r -= I4;
            prep_item(args, 5, 512, W5, scr, r, lane); }
        const float* x = args.in[0];
        for (int m = gw; m < TOK; m += NGW) { const GAS f32x4* xr = (const GAS f32x4*)(x + (size_t)m * DM) + lane; f32x4 v[4]; float s = 0.f;
#pragma unroll
            for (int j = 0; j < 4; ++j) { v[j] = xr[64 * j]; s += (v[j].x * v[j].x + v[j].y * v[j].y) + (v[j].z * v[j].z + v[j].w * v[j].w); }
            s = wave_sum(s); if (lane == 0) R0[m] = 1.0f / sqrtf(s * (1.0f / DM) + EPS);
            GAS unsigned long long* o8 = (GAS unsigned long long*)(XB + (size_t)m * DM) + lane;
#pragma unroll
            for (int j = 0; j < 4; ++j) o8[64 * j] = (unsigned long long)pk2(v[j].x, v[j].y) | ((unsigned long long)pk2(v[j].z, v[j].w) << 32); }
        const int* pos = (const int*)args.in[1];
        for (int i = gt; i < TOK * 16; i += NGT) { const int m = i >> 4, k = i & 15; const float inv = powf(10000.0f, -(float)k * (1.0f / 16.0f)); const float ang = (float)pos[m] * inv;
            float sn, cs; sincosf(ang, &sn, &cs); CS[(size_t)m * 32 + k] = cs; CS[(size_t)m * 32 + 16 + k] = sn; }
    }
    SEAM(0);
    if (IN(1)) RPT(1) { pg8::Gemm g{XB, W1, TOK, 4096, 1024}; pg8::StaticOrder S; S.init(TOK, 4096, G, bx); pg8::EpiConvIn E{VG, R0};
        pg8::gemm_phase<pg8::EpiConvIn, pg8::StaticOrder, true, true>(lds + RING_OFF, g, S, E); }
    SEAM(1);
    if (IN(2)) RPT(2) { const float* cw = args.in[4];
        for (int it = gt; it < (TOK / 16) * 128; it += NGT) { const int oct = it & 127, rc = it >> 7, t0 = rc * 16, ch = oct * 8;
            float w0[8], w1[8], w2[8];
#pragma unroll
            for (int j = 0; j < 8; ++j) { w0[j] = cw[ch + j]; w1[j] = cw[1024 + ch + j]; w2[j] = cw[2048 + ch + j]; }
            float vm2[8], vm1[8];
            const bool first = (t0 % SEQ) == 0;
#pragma unroll
            for (int h2 = 0; h2 < 2; ++h2) { v4u a = (v4u){0u, 0u, 0u, 0u}, b = a;
                if (!first) { a = *(const GAS v4u*)(VG + ((size_t)(t0 - 2) * 256 + oct * 2 + h2) * 8); b = *(const GAS v4u*)(VG + ((size_t)(t0 - 1) * 256 + oct * 2 + h2) * 8); }
                vm2[4 * h2 + 0] = pg8::bf_lo(a.x); vm2[4 * h2 + 1] = pg8::bf_hi(a.x); vm2[4 * h2 + 2] = pg8::bf_lo(a.y); vm2[4 * h2 + 3] = pg8::bf_hi(a.y);
                vm1[4 * h2 + 0] = pg8::bf_lo(b.x); vm1[4 * h2 + 1] = pg8::bf_hi(b.x); vm1[4 * h2 + 2] = pg8::bf_lo(b.y); vm1[4 * h2 + 3] = pg8::bf_hi(b.y); }
            for (int r = 0; r < 16; ++r) { const int t = t0 + r; float vc[8], gbv[8];
#pragma unroll
                for (int h2 = 0; h2 < 2; ++h2) { const v4u a = *(const GAS v4u*)(VG + ((size_t)t * 256 + oct * 2 + h2) * 8);
                    vc[4 * h2 + 0] = pg8::bf_lo(a.x); vc[4 * h2 + 1] = pg8::bf_hi(a.x); vc[4 * h2 + 2] = pg8::bf_lo(a.y); vc[4 * h2 + 3] = pg8::bf_hi(a.y);
                    gbv[4 * h2 + 0] = pg8::bf_lo(a.z); gbv[4 * h2 + 1] = pg8::bf_hi(a.z); gbv[4 * h2 + 2] = pg8::bf_lo(a.w); gbv[4 * h2 + 3] = pg8::bf_hi(a.w); }
                float yv[8];
#pragma unroll
                for (int j = 0; j < 8; ++j) { yv[j] = gbv[j] * (w0[j] * vm2[j] + w1[j] * vm1[j] + w2[j] * vc[j]); vm2[j] = vm1[j]; vm1[j] = vc[j]; }
                v4u o; o.x = pk2(yv[0], yv[1]); o.y = pk2(yv[2], yv[3]); o.z = pk2(yv[4], yv[5]); o.w = pk2(yv[6], yv[7]);
                *(GAS v4u*)(Y + (size_t)t * DM + ch) = o; } }
    }
    SEAM(2);
    if (IN(3)) RPT(3) { pg8::Gemm g{Y, W2, TOK, 1024, 1024}; pg8::StaticOrder S; S.init(TOK, 1024, G, bx); pg8::EpiResid<true> E{XB, X1B, nullptr, SS1};
        pg8::gemm_phase<pg8::EpiResid<true>, pg8::StaticOrder, true, true>(lds + RING_OFF, g, S, E); }
    SEAM(3);
    if (IN(4)) RPT(4) { pg8::Gemm g{X1B, W3, TOK, 1280, 1024}; pg8::StaticOrder S; S.init(TOK, 1280, G, bx); pg8::EpiLatent E{CKV, CQ, KR, SG, SS1, SSKV, SSQ, CS, EPS};
        pg8::gemm_phase<pg8::EpiLatent, pg8::StaticOrder, true, true>(lds + RING_OFF, g, S, E); }
    SEAM(4);
    if (IN(5)) RPT(5) {
        { pg8::Gemm g{CKV, W4A, TOK, 1024, 256}; pg8::StaticOrder S; S.init(TOK, 1024, G, bx); pg8::EpiKV E{KN, VB, SSKV, EPS};
          pg8::gemm_phase<pg8::EpiKV, pg8::StaticOrder, true, true>(lds + RING_OFF, g, S, E); }
        { pg8::Gemm g{CQ, W4B, TOK, 768, 384}; pg8::StaticOrder S; S.init(TOK, 768, G, bx); pg8::EpiQ E{QB, SSQ, CS, EPS, C2};
          pg8::gemm_phase<pg8::EpiQ, pg8::StaticOrder, true, true>(lds + RING_OFF, g, S, E); }
    }
    SEAM(5);
    if (IN(6)) RPT(6) {
        const int bh = vcu >> 1, b = bh >> 3, h = bh & 7;
        for (int i = 0; i < 8; ++i) { const int s = 4 * (vcu & 1) + (i >> 1), qb = (i & 1) ? 15 - s : s;
            att::attn_unit<8>(b, h, qb, QB, KN, KR, VB, SG, OG, lds + RING_OFF); }
        asm volatile("s_waitcnt vmcnt(0) lgkmcnt(0)" ::: "memory"); __syncthreads();
    }
    SEAM(6);
    if (IN(7)) RPT(7) { pg8::Gemm g{OG, W5, TOK, 1024, 512}; pg8::StaticOrder S; S.init(TOK, 1024, G, bx); pg8::EpiResid<false> E{X1B, nullptr, args.out, SS2};
        pg8::gemm_phase<pg8::EpiResid<false>, pg8::StaticOrder, true, true>(lds + RING_OFF, g, S, E); }
    SEAM(7);
    if (IN(8)) { const float* gf = args.in[15]; f32x4 gg[4];
#pragma unroll
        for (int j = 0; j < 4; ++j) gg[j] = ((const GAS f32x4*)gf)[lane + 64 * j];
        for (int m = gw; m < TOK; m += NGW) { const float rs = 1.0f / sqrtf(pg8::sum16f(SS2 + (size_t)m * 16) * (1.0f / DM) + EPS);
            GAS f32x4* orow = (GAS f32x4*)(args.out + (size_t)m * DM) + lane;
#pragma unroll
            for (int j = 0; j < 4; ++j) { f32x4 v = orow[64 * j]; orow[64 * j] = v * rs * gg[j]; } }
    }
#undef IN
#undef SEAM
}

extern "C" void kernel_launch(void* const* d_in, const int* in_sizes, int n_in, void* d_out, int out_size, void* d_ws, size_t ws_size, hipStream_t stream) {
    static int grid = 0;
    if (grid == 0) {
        if (n_in != 16 || in_sizes[0] != TOK * DM || out_size != TOK * DM || ws_size < WS_END) { fprintf(stderr, "kernel_launch: unexpected shapes (n_in %d, in0 %d, out %d, ws %zu)\n", n_in, n_in > 0 ? in_sizes[0] : -1, out_size, ws_size); grid = -1; return; }
        int dev = 0, cus = 0, per_cu = 0;
        if (hipGetDevice(&dev) != hipSuccess || hipDeviceGetAttribute(&cus, hipDeviceAttributeMultiprocessorCount, dev) != hipSuccess) { grid = -1; return; }
        if (hipFuncSetAttribute((const void*)yoco_fwd, hipFuncAttributeMaxDynamicSharedMemorySize, LDS_BYTES) != hipSuccess) { fprintf(stderr, "kernel_launch: hipFuncSetAttribute failed\n"); grid = -1; return; }
        if (hipOccupancyMaxActiveBlocksPerMultiprocessor(&per_cu, (const void*)yoco_fwd, NWAVES * 64, LDS_BYTES) != hipSuccess || per_cu < 1) fprintf(stderr, "kernel_launch: occupancy query reports %d\n", per_cu);
        (void)hipGetLastError();
        grid = cus;
        if (grid != 256) fprintf(stderr, "kernel_launch: %d CUs (expected 256)\n", grid);
    }
    if (grid < 0) return;
    (void)hipMemsetAsync((char*)d_ws + WS_CTL, 0, CTL_ZERO_BYTES, stream);
    Args a{};
    for (int i = 0; i < 16; ++i) a.in[i] = (const float*)d_in[i];
    a.out = (float*)d_out; a.ws = (unsigned char*)d_ws;
    constexpr int NL = MK_N_LAUNCHES;
    for (int li = 0; li < NL; ++li) {
        a.ph_lo = (NL == 1) ? 0 : li; a.ph_hi = (NL == 1) ? N_PHASES : li + 1; a.li = (NL == 1) ? 0 : 0;
        hipLaunchKernelGGL(yoco_fwd, dim3(grid), dim3(NWAVES * 64), LDS_BYTES, stream, a);
    }
}
```
